# Optimizing an MI355X kernel written in HIP

```python
import jax, jax.numpy as jnp
from jax import lax
import numpy as np

D_MODEL = 1024
BATCH = 4
SEQ = 4096
DEPTH = 1

D_ATTN = D_MODEL // 2
HEAD_DIM_A = 64
N_HEADS_A = D_ATTN // HEAD_DIM_A
DILATED_PAIRS = ((128, 1), (512, 4), (2048, 16))
D_REC = D_MODEL - D_ATTN
HGRN_EXPAND = 128
N_HEADS_R = D_REC // HGRN_EXPAND
HEAD_DIM_R = D_REC // N_HEADS_R
HGRN_CHUNK = 32
D_FORGET = N_HEADS_R * HGRN_EXPAND
D_IN = 3 * D_ATTN + 2 * D_FORGET + 2 * D_REC
N_EXPERTS = 32
TOP_K = 4
D_FF = D_MODEL
SWIGLU_LIMIT = 7.0
SWIGLU_ALPHA = 1.702
MOE_BLOCK = 128
EPS = 1e-6

kernel_name = "hymba_style_dilated_attn_hgrn2_moe_block"


def rms_norm(x, w):
    xf = x.astype(jnp.float32)
    y = xf * lax.rsqrt(jnp.mean(xf * xf, axis=-1, keepdims=True) + EPS)
    return (y * w.astype(jnp.float32)).astype(x.dtype)


def modulate(n, shift, scale):
    return n * (1.0 + scale[:, None, :]) + shift[:, None, :]


def dilated_causal_attention(q, k, v, window, dil):
    B, S, H, Dh = q.shape
    bw = window // dil
    n = S // dil
    nb = -(-n // bw)
    pad = nb * bw - n

    def sub(t):
        t = t.reshape(B, n, dil, H, Dh).transpose(0, 2, 1, 3, 4)
        return jnp.pad(t, ((0, 0), (0, 0), (0, pad), (0, 0), (0, 0)))

    def band(t):
        tp = jnp.pad(t, ((0, 0), (0, 0), (bw, 0), (0, 0), (0, 0)))
        prev = tp[:, :, :nb * bw].reshape(B, dil, nb, bw, H, Dh)
        cur = t.reshape(B, dil, nb, bw, H, Dh)
        return jnp.concatenate([prev, cur], axis=3)

    qb = sub(q).reshape(B, dil, nb, bw, H, Dh).astype(jnp.float32)
    kb = band(sub(k)).astype(jnp.float32)
    vb = band(sub(v)).astype(jnp.float32)

    r = jnp.arange(bw)[:, None]
    j = jnp.arange(2 * bw)[None, :]
    diff = bw + r - j
    kidx = (jnp.arange(nb)[:, None, None] - 1) * bw + j[None]
    mask = (diff >= 0) & (diff <= bw) & (kidx >= 0)

    s = jnp.einsum('bgiqhd,bgikhd->bgihqk', qb, kb) * (Dh ** -0.5)
    s = jnp.where(mask[None, None, :, None], s, -jnp.inf)
    m = jnp.max(s, axis=-1, keepdims=True)
    p = jnp.exp(s - m)
    l = jnp.sum(p, axis=-1, keepdims=True)
    o = jnp.einsum('bgihqk,bgikhd->bgiqhd', p, vb) / jnp.swapaxes(l, 3, 4)
    lse = jnp.swapaxes((m + jnp.log(l))[..., 0], 3, 4)

    o = o.reshape(B, dil, nb * bw, H, Dh)[:, :, :n].transpose(0, 2, 1, 3, 4).reshape(B, S, H, Dh)
    lse = lse.reshape(B, dil, nb * bw, H)[:, :, :n].transpose(0, 2, 1, 3).reshape(B, S, H)
    return o, lse


def hgrn2_chunkwise(q, k, v, log_f):
    B, S, H, DK = q.shape
    DV = v.shape[-1]
    C = HGRN_CHUNK
    nc = S // C

    def chunk(t):
        return t.astype(jnp.float32).reshape(B, nc, C, H, t.shape[-1]).transpose(0, 3, 1, 2, 4)

    q, k, v, log_f = chunk(q), chunk(k), chunk(v), chunk(log_f)
    b = jnp.cumsum(log_f, axis=3)
    qe = q * jnp.exp(b)
    ke = k * jnp.exp(-b)
    causal = jnp.tril(jnp.ones((C, C), dtype=bool))
    a = jnp.where(causal, jnp.einsum('bhncd,bhnsd->bhncs', qe, ke), 0.0)
    o_intra = jnp.einsum('bhncs,bhnse->bhnce', a, v)

    b_last = b[:, :, :, -1:, :]
    delta = jnp.einsum('bhncd,bhnce->bhnde', k * jnp.exp(b_last - b), v)
    decay = jnp.exp(b_last[:, :, :, 0, :])

    def step(state, inp):
        dec, dl = inp
        return dec[..., None] * state + dl, state

    s0 = jnp.zeros((B, H, DK, DV), jnp.float32)
    _, s_prev = lax.scan(step, s0, (jnp.moveaxis(decay, 2, 0), jnp.moveaxis(delta, 2, 0)))
    s_prev = jnp.moveaxis(s_prev, 0, 2)
    o_inter = jnp.einsum('bhncd,bhnde->bhnce', qe, s_prev)
    return (o_intra + o_inter).transpose(0, 2, 3, 1, 4).reshape(B, S, H, DV)


def hybrid_mixer(h, w_in, attn_norm_w, lb, hgrn_norm_w, w_out):
    B, S, _ = h.shape
    proj = h @ w_in
    widths = [D_ATTN, D_ATTN, D_ATTN, D_FORGET, D_FORGET, D_REC, D_REC]
    cuts = [int(v) for v in np.cumsum(widths)[:-1]]
    qa, ka, va, qr, fr, ir, gr = jnp.split(proj, cuts, axis=-1)

    qa = qa.reshape(B, S, N_HEADS_A, HEAD_DIM_A)
    ka = ka.reshape(B, S, N_HEADS_A, HEAD_DIM_A)
    va = va.reshape(B, S, N_HEADS_A, HEAD_DIM_A)
    outs, lses = [], []
    for window, dil in DILATED_PAIRS:
        o, lse = dilated_causal_attention(qa, ka, va, window, dil)
        outs.append(o)
        lses.append(lse)
    wts = jax.nn.softmax(jnp.stack(lses, axis=0), axis=0)
    o_a = jnp.einsum('nbsh,nbshd->bshd', wts, jnp.stack(outs, axis=0)).astype(h.dtype)
    y_a = rms_norm(o_a, attn_norm_w.reshape(N_HEADS_A, HEAD_DIM_A)).reshape(B, S, D_ATTN)

    q_r = jax.nn.silu(qr.astype(jnp.float32)).reshape(B, S, N_HEADS_R, HGRN_EXPAND)
    lb_h = lb.reshape(N_HEADS_R, HGRN_EXPAND)
    f = lb_h + (1.0 - lb_h) * jax.nn.sigmoid(fr.astype(jnp.float32).reshape(B, S, N_HEADS_R, HGRN_EXPAND))
    v_r = ir.reshape(B, S, N_HEADS_R, HEAD_DIM_R)
    o_r = hgrn2_chunkwise(q_r, 1.0 - f, v_r, jnp.log(f)).astype(h.dtype)
    o_r = rms_norm(o_r, hgrn_norm_w.reshape(N_HEADS_R, HEAD_DIM_R)).reshape(B, S, D_REC)
    y_r = o_r * jax.nn.silu(gr)

    return jnp.concatenate([y_a, y_r], axis=-1) @ w_out


def moe_ffn(h, w_router, b_router, w_gu, b_gu, w_down, b_down):
    B, S, D = h.shape
    T = B * S
    ht = h.reshape(T, D)
    logits = (ht @ w_router + b_router).astype(jnp.float32)
    top_val, top_idx = lax.top_k(logits, TOP_K)
    gates = jax.nn.softmax(top_val, axis=-1)

    flat_e = top_idx.reshape(-1)
    flat_tok = jnp.arange(T * TOP_K, dtype=jnp.int32) // TOP_K
    flat_gate = gates.reshape(-1)
    order = jnp.argsort(flat_e)
    se, stok, sgate = flat_e[order], flat_tok[order], flat_gate[order]
    counts = jnp.zeros((N_EXPERTS,), jnp.int32).at[flat_e].add(1)
    padded = ((counts + MOE_BLOCK - 1) // MOE_BLOCK) * MOE_BLOCK
    pend = jnp.cumsum(padded)
    pstart = pend - padded
    sstart = jnp.cumsum(counts) - counts
    rank = jnp.arange(T * TOP_K, dtype=jnp.int32) - sstart[se]
    dest = pstart[se] + rank
    P = T * TOP_K + N_EXPERTS * MOE_BLOCK
    nblk = P // MOE_BLOCK
    tok_pad = jnp.full((P,), T, jnp.int32).at[dest].set(stok)
    gate_pad = jnp.zeros((P,), h.dtype).at[dest].set(sgate.astype(h.dtype))
    blk_e = jnp.minimum(jnp.searchsorted(pend, jnp.arange(nblk) * MOE_BLOCK, side='right'),
                        N_EXPERTS - 1).astype(jnp.int32)
    x_pad = jnp.concatenate([ht, jnp.zeros((1, D), ht.dtype)], axis=0)
    xb = x_pad[tok_pad].reshape(nblk, MOE_BLOCK, D)

    def expert_block(args):
        xblk, e = args
        hg = xblk @ w_gu[e] + b_gu[e]
        x_glu, x_lin = hg[:, :D_FF], hg[:, D_FF:]
        x_glu = jnp.minimum(x_glu, SWIGLU_LIMIT)
        x_lin = jnp.clip(x_lin, -SWIGLU_LIMIT, SWIGLU_LIMIT)
        act = x_glu * jax.nn.sigmoid(SWIGLU_ALPHA * x_glu) * (x_lin + 1.0)
        return act @ w_down[e] + b_down[e]

    yb = lax.map(expert_block, (xb, blk_e))
    y = yb.reshape(P, D) * gate_pad[:, None]
    out = jnp.zeros((T + 1, D), y.dtype).at[tok_pad].add(y)[:T]
    return out.reshape(B, S, D)


def setup_inputs(seed: int = 0) -> dict:
    key = jax.random.key(seed)
    ks = jax.random.split(key, 20)

    def nrm(k, shape, scale):
        return jax.random.normal(k, shape, jnp.float32) * scale

    return {
        "x": nrm(ks[0], (BATCH, SEQ, D_MODEL), 1.0),
        "c": nrm(ks[1], (BATCH, D_MODEL), 1.0),
        "w_ada": nrm(ks[2], (DEPTH, D_MODEL, 6 * D_MODEL), 0.5 * D_MODEL ** -0.5),
        "b_ada": nrm(ks[3], (DEPTH, 6 * D_MODEL), 0.02),
        "g_pre_mix": 1.0 + nrm(ks[4], (DEPTH, D_MODEL), 0.05),
        "g_post_mix": 1.0 + nrm(ks[5], (DEPTH, D_MODEL), 0.05),
        "w_in": nrm(ks[6], (DEPTH, D_MODEL, D_IN), D_MODEL ** -0.5),
        "attn_norm_w": 1.0 + nrm(ks[7], (DEPTH, D_ATTN), 0.05),
        "hgrn_lb": nrm(ks[8], (DEPTH + 1, D_FORGET), 0.5),
        "hgrn_norm_w": 1.0 + nrm(ks[9], (DEPTH, D_REC), 0.05),
        "w_out": nrm(ks[10], (DEPTH, D_MODEL, D_MODEL), D_MODEL ** -0.5),
        "g_pre_ffn": 1.0 + nrm(ks[11], (DEPTH, D_MODEL), 0.05),
        "g_post_ffn": 1.0 + nrm(ks[12], (DEPTH, D_MODEL), 0.05),
        "w_router": nrm(ks[13], (DEPTH, D_MODEL, N_EXPERTS), D_MODEL ** -0.5),
        "b_router": nrm(ks[14], (DEPTH, N_EXPERTS), 0.01),
        "w_gu": nrm(ks[15], (DEPTH, N_EXPERTS, D_MODEL, 2 * D_FF), D_MODEL ** -0.5),
        "b_gu": nrm(ks[16], (DEPTH, N_EXPERTS, 2 * D_FF), 0.02),
        "w_down": nrm(ks[17], (DEPTH, N_EXPERTS, D_FF, D_MODEL), D_FF ** -0.5),
        "b_down": nrm(ks[18], (DEPTH, N_EXPERTS, D_MODEL), 0.02),
    }


def reference(x, c, w_ada, b_ada, g_pre_mix, g_post_mix, w_in, attn_norm_w, hgrn_lb,
              hgrn_norm_w, w_out, g_pre_ffn, g_post_ffn, w_router, b_router, w_gu, b_gu,
              w_down, b_down):
    lb_table = jnp.cumsum(jax.nn.softmax(hgrn_lb.astype(jnp.float32), axis=0), axis=0)
    cond = jax.nn.silu(c)
    for l in range(DEPTH):
        mod = cond @ w_ada[l] + b_ada[l]
        shift_m, scale_m, gate_m, shift_f, scale_f, gate_f = jnp.split(mod, 6, axis=-1)
        h = modulate(rms_norm(x, g_pre_mix[l]), shift_m, scale_m)
        y = hybrid_mixer(h, w_in[l], attn_norm_w[l], lb_table[l], hgrn_norm_w[l], w_out[l])
        x = x + gate_m[:, None, :] * rms_norm(y, g_post_mix[l])
        h = modulate(rms_norm(x, g_pre_ffn[l]), shift_f, scale_f)
        y = moe_ffn(h, w_router[l], b_router[l], w_gu[l], b_gu[l], w_down[l], b_down[l])
        x = x + gate_f[:, None, :] * rms_norm(y, g_post_ffn[l])
    return x
```

```cpp
#include <hip/hip_runtime.h>
#include <cstdio>
#include <cstdint>

#ifndef MK_N_LAUNCHES
#define MK_N_LAUNCHES 1
#endif

#define LAS __attribute__((address_space(3)))
#define GAS __attribute__((address_space(1)))
typedef unsigned short bf16_t;
typedef short bf16x8 __attribute__((ext_vector_type(8)));
typedef short s16x4 __attribute__((ext_vector_type(4)));
typedef short v4i16_t __attribute__((ext_vector_type(4)));
typedef float f32x2 __attribute__((ext_vector_type(2)));
typedef float f32x4 __attribute__((ext_vector_type(4)));
typedef float f32x16 __attribute__((ext_vector_type(16)));
typedef unsigned u32x2 __attribute__((ext_vector_type(2)));
typedef unsigned u32x4 __attribute__((ext_vector_type(4)));
typedef __bf16 bf16x2_t __attribute__((ext_vector_type(2)));

constexpr int D = 1024, NB = 4, SEQ = 4096, T = NB * SEQ;
constexpr int DIN = 3584;
constexpr int C_QA = 0, C_KA = 512, C_VA = 1024, C_QR = 1536, C_FR = 2048, C_IR = 2560, C_GR = 3072;
constexpr int NE = 32;
constexpr float EPS = 1e-6f;
constexpr int NPHASE = 11;
constexpr int LIST_CAP = 16384;
constexpr int ACT_ROWS = T * 4 + NE * 256;

constexpr size_t MiB = 1u << 20;
constexpr size_t WS_CTL = 0, CTL_ZERO_BYTES = 1 * MiB;
constexpr size_t WS_MOD = 1 * MiB;
constexpr size_t WS_WIN = 2 * MiB;
constexpr size_t WS_WOUT = 10 * MiB;
constexpr size_t WS_WGU = 16 * MiB;
constexpr size_t WS_WDN = 144 * MiB;
constexpr size_t WS_H = 208 * MiB;
constexpr size_t WS_PROJ = 240 * MiB;
constexpr size_t WS_YCAT = 352 * MiB;
constexpr size_t WS_ACT = 240 * MiB;
constexpr size_t WS_PARTO = 384 * MiB;
constexpr size_t WS_LSE = 432 * MiB;
constexpr size_t WS_OLOC = 434 * MiB;
constexpr size_t WS_QE = 450 * MiB;
constexpr size_t WS_SLOC = 466 * MiB;
constexpr size_t WS_DTOT = 482 * MiB;
constexpr size_t WS_SIN = 483 * MiB;
constexpr size_t WS_Y = 492 * MiB;
constexpr size_t WS_YPAIR = 384 * MiB;
constexpr size_t WS_X2 = 556 * MiB;
constexpr size_t WS_TOK = 620 * MiB;
constexpr size_t WS_GATE = 622 * MiB;
constexpr size_t WS_END = 624 * MiB;
static_assert(WS_ACT + (size_t)ACT_ROWS * 2048 <= WS_PARTO, "act overlay");
static_assert(WS_YPAIR + (size_t)T * 4 * 2048 <= WS_X2, "ypair overlay");

constexpr int CW_TMO = 0;
constexpr int CW_BAR = 4096;
constexpr int CW_CNT = 8192;

constexpr int RING_BYTES = 131072;
constexpr int MISC_OFF = RING_BYTES;
constexpr int IDXBUF_OFF = RING_BYTES + 8192;
constexpr int BARW_OFF = RING_BYTES + 16384 - 16;
constexpr int LDS_BYTES = RING_BYTES + 16384;

__device__ __forceinline__ float bf2f(unsigned v) { return __uint_as_float(v << 16); }
__device__ __forceinline__ float bflo(unsigned v) { return __uint_as_float(v << 16); }
__device__ __forceinline__ float bfhi(unsigned v) { return __uint_as_float(v & 0xffff0000u); }
__device__ __forceinline__ unsigned pk2(float lo, float hi) { f32x2 v = {lo, hi}; bf16x2_t b = __builtin_convertvector(v, bf16x2_t); return __builtin_bit_cast(unsigned, b); }
__device__ __forceinline__ float wave_sum(float v) {
#pragma unroll
    for (int o = 32; o >= 1; o >>= 1) v += __shfl_xor(v, o);
    return v;
}
__device__ __forceinline__ float sigmoidf_(float x) { return 1.f / (1.f + __expf(-x)); }
__device__ __forceinline__ int crow(int r, int hi) { return (r & 3) + 8 * (r >> 2) + 4 * hi; }
__device__ __forceinline__ s16x4 tr_read(const LAS unsigned char* p) { return __builtin_bit_cast(s16x4, __builtin_amdgcn_ds_read_tr16_b64_v4i16((LAS v4i16_t*)p)); }
__device__ __forceinline__ bf16x8 cat8(s16x4 lo, s16x4 hi) { return (bf16x8){lo[0], lo[1], lo[2], lo[3], hi[0], hi[1], hi[2], hi[3]}; }
__device__ __forceinline__ bf16x8 pack_step(const f32x16& x, int s) {
    u32x4 p; p.x = pk2(x[8 * s], x[8 * s + 1]); p.y = pk2(x[8 * s + 2], x[8 * s + 3]); p.z = pk2(x[8 * s + 4], x[8 * s + 5]); p.w = pk2(x[8 * s + 6], x[8 * s + 7]);
    return __builtin_bit_cast(bf16x8, p);
}
#define MFMA32(a, b, c) __builtin_amdgcn_mfma_f32_32x32x16_bf16((a), (b), (c), 0, 0, 0)

#define XB_TMO      128
#define XB_XCNT(j)  (256  + 64 * (j))
#define XB_XSUB(j)  (1280 + 64 * (j))
#define XB_XGEN(j)  (2304 + 64 * (j))
#define XB_TOP      3328
#define XB_TOPGEN   3392
#define XCD_BAR_WORDS 3456
#define XB_SPIN_CAP (1u << 18)
__device__ __forceinline__ unsigned xb_ld(unsigned* p)              { return __hip_atomic_load(p, __ATOMIC_RELAXED, __HIP_MEMORY_SCOPE_AGENT); }
__device__ __forceinline__ unsigned xb_add(unsigned* p, unsigned v) { return __hip_atomic_fetch_add(p, v, __ATOMIC_RELAXED, __HIP_MEMORY_SCOPE_AGENT); }
__device__ __forceinline__ unsigned xb_xcc_id() { return (unsigned)__builtin_amdgcn_s_getreg((3 << 11) | 20) & 0xFu; }
#define XB_SPIN(cond, bar) do { unsigned _sp = 0; while (cond) { __builtin_amdgcn_s_sleep(1); \
    if ((++_sp & 255u) == 0u) { if (xb_ld(&(bar)[XB_TMO])) break; if (_sp > XB_SPIN_CAP) { atomicAdd(&(bar)[XB_TMO], 1u); break; } } } } while (0)
struct XcdBarrier { unsigned* bar; unsigned x; volatile LAS unsigned* st; };
__device__ __forceinline__ XcdBarrier xcd_barrier_post(unsigned* bar, volatile LAS unsigned* st) {
    XcdBarrier b; b.bar = bar; b.x = xb_xcc_id(); b.st = st;
    if (threadIdx.x == 0) (void)xb_add(&bar[XB_XCNT(b.x)], 1u);
    return b;
}
__device__ __forceinline__ void xcd_barrier_complete(unsigned* bar, unsigned x, unsigned& nloc, unsigned& nx) {
    const unsigned G = gridDim.x * gridDim.y * gridDim.z;
    unsigned sum, cnt, mine, sp = 0u;
    for (;;) {
        sum = 0u; cnt = 0u; mine = 0u;
#pragma unroll
        for (unsigned j = 0; j < 16; ++j) { const unsigned c = xb_ld(&bar[XB_XCNT(j)]); sum += c; cnt += (c > 0u) ? 1u : 0u; mine = (j == x) ? c : mine; }
        if (sum == G) break;
        __builtin_amdgcn_s_sleep(1);
        if ((++sp & 255u) == 0u) { if (xb_ld(&bar[XB_TMO])) break; if (sp > XB_SPIN_CAP) { atomicAdd(&bar[XB_TMO], 1u); break; } }
    }
    nloc = mine > 0u ? mine : 1u; nx = cnt > 0u ? cnt : 1u;
}
__device__ __forceinline__ void xcd_barrier(const XcdBarrier& b) {
    asm volatile("s_waitcnt vmcnt(0)" ::: "memory");
    __syncthreads();
    if (threadIdx.x == 0) {
        unsigned* bar = b.bar;
        __builtin_amdgcn_s_waitcnt(0);
        unsigned nloc = b.st[0], nx = b.st[1];
        if (nloc == 0u) { xcd_barrier_complete(bar, b.x, nloc, nx); b.st[0] = nloc; b.st[1] = nx; }
        const unsigned old = xb_add(&bar[XB_XSUB(b.x)], 1u);
        const unsigned gen = old / nloc;
        if (old + 1u == (gen + 1u) * nloc) {
            __builtin_amdgcn_fence(__ATOMIC_RELEASE, "agent");
            asm volatile("s_waitcnt vmcnt(0)" ::: "memory");
            const unsigned og = xb_add(&bar[XB_TOP], 1u);
            const unsigned tg = og / nx;
            if (og + 1u == (tg + 1u) * nx) xb_add(&bar[XB_TOPGEN], 1u);
            else XB_SPIN(xb_ld(&bar[XB_TOPGEN]) == tg, bar);
            __builtin_amdgcn_fence(__ATOMIC_ACQUIRE, "agent");
            xb_add(&bar[XB_XGEN(b.x)], 1u);
            asm volatile("s_waitcnt vmcnt(0)" ::: "memory");
        } else {
            XB_SPIN(xb_ld(&bar[XB_XGEN(b.x)]) == gen, bar);
            __builtin_amdgcn_fence(__ATOMIC_ACQUIRE, "agent");
            asm volatile("s_waitcnt vmcnt(0)" ::: "memory");
        }
    }
    __syncthreads();
}

namespace pg8 {
constexpr int BM = 256, BK = 64, HALF = 128, HTB = HALF * BK * 2, NXCD = 8, WGM = 8, KD = 1024;
__host__ __device__ __forceinline__ int lds_byte(int r, int c) { const int st = (r >> 4) * 2 + (c >> 5), rr = r & 15, cc = c & 31, ob = rr * 64 + cc * 2; return st * 1024 + (ob ^ (((ob >> 9) & 1) << 5)); }
__host__ __device__ __forceinline__ void stage_rc(int b, int& R, int& C) { const int st = b / 1024, sb = b % 1024, swz = sb ^ (((sb >> 9) & 1) << 5); R = (st >> 1) * 16 + swz / 64; C = (st & 1) * 32 + (swz % 64) / 2; }
__host__ __device__ __forceinline__ int perm32(int rho) { const int n = rho >> 4, i = rho & 15; return 8 * (i >> 2) + 4 * n + (i & 3); }

struct Unit { int pm, pn, e, rt, nvalid; };

struct StaticOrder {
    int nM, nN, nwg, G, c;
    __device__ void init(int M, int N, int G_, int c_) { nM = M / BM; nN = N / BM; nwg = nM * nN; G = G_; c = c_; }
    __device__ bool next(int i, Unit& u) const {
        const long L = (long)i * G + c; if (L >= nwg) return false;
        int wgid = (int)L; { const int q = nwg / NXCD, r = nwg % NXCD, xcd = wgid % NXCD, off = wgid / NXCD; wgid = (xcd < r ? xcd * (q + 1) : r * (q + 1) + (xcd - r) * q) + off; }
        const int nig = WGM * nN, gid = wgid / nig, fm = gid * WGM, gsz = (nM - fm) < WGM ? (nM - fm) : WGM;
        u.pm = fm + ((wgid % nig) % gsz); u.pn = (wgid % nig) / gsz; u.e = 0; u.rt = 0; u.nvalid = 256; return true;
    }
};
struct MoeOrder {
    const LAS int* cnt; const LAS int* tbase; const LAS int* tile_e; int ncol, G, c;
    __device__ bool next(int i, Unit& u) const {
        const int NT = tbase[NE]; const long L = (long)i * G + c; if (L >= (long)NT * ncol) return false;
        const int gt = (int)(L / ncol); const int e = tile_e[gt];
        u.pm = __builtin_amdgcn_readfirstlane(gt); u.pn = __builtin_amdgcn_readfirstlane((int)(L % ncol)); u.e = __builtin_amdgcn_readfirstlane(e);
        u.rt = __builtin_amdgcn_readfirstlane(gt - tbase[e]); const int left = cnt[e] - u.rt * 256; u.nvalid = __builtin_amdgcn_readfirstlane(left < 256 ? left : 256); return true;
    }
};
struct ProbPlain {
    static constexpr bool GATHER = false;
    const bf16_t* A; const bf16_t* Bt;
    __device__ __forceinline__ const char* a_ptr(const Unit& u) const { return (const char*)A + (size_t)u.pm * (256 * KD * 2); }
    __device__ __forceinline__ const char* b_ptr(const Unit& u) const { return (const char*)Bt + (size_t)u.pn * (256 * KD * 2); }
    __device__ __forceinline__ const int* list_ptr(const Unit&) const { return nullptr; }
};
struct ProbGU {
    static constexpr bool GATHER = true;
    const bf16_t* A; const bf16_t* Bt; const int* list;
    __device__ __forceinline__ const char* a_ptr(const Unit&) const { return (const char*)A; }
    __device__ __forceinline__ const char* b_ptr(const Unit& u) const { return (const char*)Bt + ((size_t)u.e * 2048 + (size_t)u.pn * 256) * (KD * 2); }
    __device__ __forceinline__ const int* list_ptr(const Unit& u) const { return list + (size_t)u.e * LIST_CAP + u.rt * 256; }
};
struct ProbDown {
    static constexpr bool GATHER = false;
    const bf16_t* A; const bf16_t* Bt;
    __device__ __forceinline__ const char* a_ptr(const Unit& u) const { return (const char*)A + (size_t)u.pm * (256 * KD * 2); }
    __device__ __forceinline__ const char* b_ptr(const Unit& u) const { return (const char*)Bt + ((size_t)u.e * 1024 + (size_t)u.pn * 256) * (KD * 2); }
    __device__ __forceinline__ const int* list_ptr(const Unit&) const { return nullptr; }
};

struct EpiBf16 {
    static constexpr bool PERM = true;
    bf16_t* O; int ldc;
    __device__ __forceinline__ void operator()(const f32x4 (&acc)[2][2][4][2], const Unit& u, int wr, int wc, int fr, int fq) const {
        const int row0 = u.pm * BM + wr * 64 + fr, col0 = u.pn * BM + wc * 32 + 8 * fq;
#pragma unroll
        for (int ai = 0; ai < 2; ++ai)
#pragma unroll
            for (int m = 0; m < 4; ++m) { bf16_t* rowp = O + (size_t)(row0 + ai * HALF + m * 16) * ldc + col0;
#pragma unroll
                for (int bj = 0; bj < 2; ++bj) { const f32x4 v0 = acc[ai][bj][m][0], v1 = acc[ai][bj][m][1];
                    u32x4 w; w.x = pk2(v0[0], v0[1]); w.y = pk2(v0[2], v0[3]); w.z = pk2(v1[0], v1[1]); w.w = pk2(v1[2], v1[3]);
                    *(u32x4*)(rowp + bj * HALF) = w; } }
    }
};
struct EpiF32 {
    static constexpr bool PERM = false;
    float* C; int ldc;
    __device__ __forceinline__ void operator()(const f32x4 (&acc)[2][2][4][2], const Unit& u, int wr, int wc, int fr, int fq) const {
        const int row0 = u.pm * BM + wr * 64 + fr, col0 = u.pn * BM + wc * 32 + 4 * fq;
#pragma unroll
        for (int ai = 0; ai < 2; ++ai)
#pragma unroll
            for (int m = 0; m < 4; ++m) { float* rowp = C + (size_t)(row0 + ai * HALF + m * 16) * ldc + col0;
#pragma unroll
                for (int bj = 0; bj < 2; ++bj)
#pragma unroll
                    for (int n = 0; n < 2; ++n) *(f32x4*)(rowp + bj * HALF + n * 16) = acc[ai][bj][m][n]; }
    }
};
struct EpiGU {
    static constexpr bool PERM = true;
    bf16_t* act; const float* b_gu;
    __device__ __forceinline__ void operator()(const f32x4 (&acc)[2][2][4][2], const Unit& u, int wr, int wc, int fr, int fq) const {
        const int row0 = u.pm * BM + wr * 64 + fr, col0 = u.pn * 128 + wc * 32 + 8 * fq;
        const float* bg = b_gu + (size_t)u.e * 2048 + col0;
        const f32x4 bg0 = *(const f32x4*)(bg), bg1 = *(const f32x4*)(bg + 4), bl0 = *(const f32x4*)(bg + 1024), bl1 = *(const f32x4*)(bg + 1028);
#pragma unroll
        for (int ai = 0; ai < 2; ++ai)
#pragma unroll
            for (int m = 0; m < 4; ++m) {
                float r[8];
#pragma unroll
                for (int n = 0; n < 2; ++n)
#pragma unroll
                    for (int j = 0; j < 4; ++j) {
                        float g = acc[ai][0][m][n][j] + (n ? bg1[j] : bg0[j]); float l = acc[ai][1][m][n][j] + (n ? bl1[j] : bl0[j]);
                        g = fminf(g, 7.0f); l = fminf(fmaxf(l, -7.0f), 7.0f);
                        r[n * 4 + j] = g * (1.f / (1.f + __expf(-1.702f * g))) * (l + 1.0f); }
                u32x4 w; w.x = pk2(r[0], r[1]); w.y = pk2(r[2], r[3]); w.z = pk2(r[4], r[5]); w.w = pk2(r[6], r[7]);
                *(u32x4*)(act + (size_t)(row0 + ai * HALF + m * 16) * 1024 + col0) = w; }
    }
};
struct EpiDown {
    static constexpr bool PERM = true;
    bf16_t* ypair; const float* b_down; const float* gate; const int* list;
    __device__ __forceinline__ void operator()(const f32x4 (&acc)[2][2][4][2], const Unit& u, int wr, int wc, int fr, int fq) const {
        const int col0 = u.pn * BM + wc * 32 + 8 * fq;
        const float* bd = b_down + (size_t)u.e * 1024 + col0;
        f32x4 bv[2][2];
#pragma unroll
        for (int bj = 0; bj < 2; ++bj)
#pragma unroll
            for (int n = 0; n < 2; ++n) bv[bj][n] = *(const f32x4*)(bd + bj * HALF + 4 * n);
        const int* lp = list + (size_t)u.e * LIST_CAP + u.rt * 256;
#pragma unroll
        for (int ai = 0; ai < 2; ++ai)
#pragma unroll
            for (int m = 0; m < 4; ++m) {
                const int r = ai * HALF + wr * 64 + m * 16 + fr;
                if (r < u.nvalid) {
                    const int pair = lp[r]; const float gt = gate[pair];
                    bf16_t* rowp = ypair + (size_t)pair * 1024 + col0;
#pragma unroll
                    for (int bj = 0; bj < 2; ++bj) { const f32x4 v0 = (acc[ai][bj][m][0] + bv[bj][0]) * gt, v1 = (acc[ai][bj][m][1] + bv[bj][1]) * gt;
                        u32x4 w; w.x = pk2(v0[0], v0[1]); w.y = pk2(v0[2], v0[3]); w.z = pk2(v1[0], v1[1]); w.w = pk2(v1[2], v1[3]);
                        *(u32x4*)(rowp + bj * HALF) = w; }
                }
            }
    }
};

template <class Epi, class Sched, class Prob>
__device__ __forceinline__ void gemm_phase(LAS unsigned char* lds, const Prob& P, const Sched& S, const Epi& E) {
    const int tid = threadIdx.x, wid = __builtin_amdgcn_readfirstlane(tid >> 6), lane = tid & 63, wr = wid >> 2, wc = wid & 3, fr = lane & 15, fq = lane >> 4;
    constexpr int K = KD, nt = K / BK;
    unsigned voffA[2], voffB[2];
#pragma unroll
    for (int i = 0; i < 2; ++i) { int R, C; stage_rc(tid * 16 + i * 8192, R, C); const int Rb = Epi::PERM ? ((R & ~31) + perm32(R & 31)) : R;
        voffA[i] = (unsigned)(R * K + C) * 2u; voffB[i] = (unsigned)(Rb * K + C) * 2u; }
    unsigned voffG[2][2] = {{0u, 0u}, {0u, 0u}};
    LAS int* idxbuf = (LAS int*)(lds + IDXBUF_OFF);
    const size_t kstep = (size_t)(BK * 2);
    const size_t hstep = (size_t)HALF * K * 2;
    const unsigned ldsw = (unsigned)wid * 1024u;
    const int aoff = lds_byte(wr * 64 + fr, fq * 8), boff = lds_byte(wc * 32 + fr, fq * 8);
#define PG8_SA(b, h) (((b) * 2 + (h)) * HTB)
#define PG8_SB(b, h) ((4 + (b) * 2 + (h)) * HTB)
#define PG8_STAGE(bufoff, gbase, voff) do { _Pragma("unroll") for (int _i = 0; _i < 2; ++_i) \
        __builtin_amdgcn_global_load_lds((const unsigned*)((const char*)(gbase) + (voff)[_i]), (LAS unsigned*)(lds + (bufoff) + ldsw + _i * 8192), 16, 0, 0); } while (0)
#define PG8_ASTAGE(bufoff, gbase, h) do { if constexpr (Prob::GATHER) { PG8_STAGE(bufoff, gbase, voffG[h]); } else { PG8_STAGE(bufoff, (gbase) + (h) * hstep, voffA); } } while (0)
#define PG8_LDA(dst, b, h) do { _Pragma("unroll") for (int m = 0; m < 4; ++m) _Pragma("unroll") for (int k = 0; k < 2; ++k) dst[m][k] = *(const LAS bf16x8*)(lds + PG8_SA(b, h) + aoff + m * 2048 + k * 1024); } while (0)
#define PG8_LDB(dst, b, h) do { _Pragma("unroll") for (int n = 0; n < 2; ++n) _Pragma("unroll") for (int k = 0; k < 2; ++k) dst[n][k] = *(const LAS bf16x8*)(lds + PG8_SB(b, h) + boff + n * 2048 + k * 1024); } while (0)
#define PG8_MMA(ai, bj, At, Bt) do { __builtin_amdgcn_s_setprio(1); _Pragma("unroll") for (int m = 0; m < 4; ++m) _Pragma("unroll") for (int n = 0; n < 2; ++n) _Pragma("unroll") for (int k = 0; k < 2; ++k) \
        acc[ai][bj][m][n] = __builtin_amdgcn_mfma_f32_16x16x32_bf16(Bt[n][k], At[m][k], acc[ai][bj][m][n], 0, 0, 0); __builtin_amdgcn_s_setprio(0); } while (0)
#define PG8_WAIT_V(n) asm volatile("s_waitcnt vmcnt(" #n ")" ::: "memory")
#define PG8_WAIT_L(n) asm volatile("s_waitcnt lgkmcnt(" #n ")" ::: "memory")
#define PG8_BAR __builtin_amdgcn_s_barrier()
#define PG8_SCHED __builtin_amdgcn_sched_barrier(0)
    Unit cur, nxt; int ui = 0;
    if (!S.next(0, cur)) return;
    f32x4 acc[2][2][4][2];
#pragma unroll
    for (int a = 0; a < 2; ++a)
#pragma unroll
        for (int b = 0; b < 2; ++b)
#pragma unroll
            for (int m = 0; m < 4; ++m)
#pragma unroll
                for (int n = 0; n < 2; ++n) acc[a][b][m][n] = (f32x4){0.f, 0.f, 0.f, 0.f};
    bf16x8 At[4][2], B0[2][2], B1[2][2];
    const char* cA = P.a_ptr(cur); const char* cB = P.b_ptr(cur);
    if constexpr (Prob::GATHER) {
        const int* lp = P.list_ptr(cur); const int R0 = (wid >> 1) * 16 + (lane >> 2); const unsigned coff = (unsigned)((wid & 1) * 32 + (((lane & 3) * 8) ^ ((lane >> 5) << 4))) * 2u;
#pragma unroll
        for (int h = 0; h < 2; ++h)
#pragma unroll
            for (int i = 0; i < 2; ++i) { const int row = h * 128 + R0 + 64 * i; const int pair = (row < cur.nvalid) ? lp[row] : 0; voffG[h][i] = (unsigned)(pair >> 2) * (unsigned)(K * 2) + coff; }
        Unit u1; if (S.next(1, u1) && tid < 256) idxbuf[256 + tid] = P.list_ptr(u1)[tid];
    }
    PG8_STAGE(PG8_SB(0, 0), cB, voffB); PG8_STAGE(PG8_SB(0, 1), cB + hstep, voffB); PG8_ASTAGE(PG8_SA(0, 0), cA, 0); PG8_ASTAGE(PG8_SA(0, 1), cA, 1);
    if (wr == 1) PG8_BAR;
    PG8_WAIT_V(2); PG8_BAR;
    PG8_STAGE(PG8_SB(1, 0), cB + kstep, voffB); PG8_ASTAGE(PG8_SA(1, 0), cA + kstep, 0); PG8_STAGE(PG8_SB(1, 1), cB + hstep + kstep, voffB);
    PG8_WAIT_V(6); PG8_BAR;
    for (;;) {
        const bool has_next = S.next(ui + 1, nxt);
        const char* nA = has_next ? P.a_ptr(nxt) : cA; const char* nB = has_next ? P.b_ptr(nxt) : cB;
        for (int t = 0; t < nt; t += 2) {
            const bool last = (t == nt - 2);
            const char* a1 = cA + (size_t)(t + 1) * kstep;
            const char* a2 = last ? nA : cA + (size_t)(t + 2) * kstep; const char* b2 = last ? nB : cB + (size_t)(t + 2) * kstep;
            const char* a3 = a2 + kstep; const char* b3 = b2 + kstep;
            PG8_LDB(B0, 0, 0); PG8_LDB(B1, 0, 1); PG8_SCHED; PG8_LDA(At, 0, 0); PG8_ASTAGE(PG8_SA(1, 1), a1, 1);
            if constexpr (Prob::GATHER) { if (last && has_next) {
                const int R0 = (wid >> 1) * 16 + (lane >> 2); const unsigned coff = (unsigned)((wid & 1) * 32 + (((lane & 3) * 8) ^ ((lane >> 5) << 4))) * 2u; const LAS int* ib = idxbuf + ((ui + 1) & 1) * 256;
#pragma unroll
                for (int h = 0; h < 2; ++h)
#pragma unroll
                    for (int i = 0; i < 2; ++i) { const int row = h * 128 + R0 + 64 * i; const int pair = (row < nxt.nvalid) ? ib[row] : 0; voffG[h][i] = (unsigned)(pair >> 2) * (unsigned)(K * 2) + coff; } } }
            PG8_WAIT_V(8); PG8_WAIT_L(0); PG8_BAR; PG8_MMA(0, 0, At, B0); PG8_MMA(0, 1, At, B1); PG8_BAR; PG8_SCHED;
            PG8_LDA(At, 0, 1); PG8_STAGE(PG8_SB(0, 0), b2, voffB); PG8_STAGE(PG8_SB(0, 1), b2 + hstep, voffB); PG8_ASTAGE(PG8_SA(0, 0), a2, 0);
            PG8_WAIT_V(8); PG8_WAIT_L(0); PG8_BAR; PG8_MMA(1, 0, At, B0); PG8_MMA(1, 1, At, B1); PG8_BAR; PG8_SCHED;
            PG8_LDB(B0, 1, 0); PG8_LDB(B1, 1, 1); PG8_SCHED; PG8_LDA(At, 1, 0); PG8_ASTAGE(PG8_SA(0, 1), a2, 1);
            PG8_WAIT_V(8); PG8_WAIT_L(0); PG8_BAR; PG8_MMA(0, 0, At, B0); PG8_MMA(0, 1, At, B1); PG8_BAR; PG8_SCHED;
            PG8_LDA(At, 1, 1); PG8_STAGE(PG8_SB(1, 0), b3, voffB); PG8_STAGE(PG8_SB(1, 1), b3 + hstep, voffB); PG8_ASTAGE(PG8_SA(1, 0), a3, 0);
            PG8_WAIT_V(8); PG8_WAIT_L(0); PG8_BAR; PG8_MMA(1, 0, At, B0); PG8_MMA(1, 1, At, B1); PG8_BAR; PG8_SCHED;
        }
        if (wr == 0) PG8_BAR;
        E(acc, cur, wr, wc, fr, fq);
        if constexpr (Prob::GATHER) { Unit u2; if (S.next(ui + 2, u2) && tid < 256) idxbuf[(ui & 1) * 256 + tid] = P.list_ptr(u2)[tid]; }
        if (!has_next) break;
#pragma unroll
        for (int a = 0; a < 2; ++a)
#pragma unroll
            for (int b = 0; b < 2; ++b)
#pragma unroll
                for (int m = 0; m < 4; ++m)
#pragma unroll
                    for (int n = 0; n < 2; ++n) acc[a][b][m][n] = (f32x4){0.f, 0.f, 0.f, 0.f};
        cur = nxt; cA = nA; cB = nB; ++ui;
        if (wr == 1) PG8_BAR;
    }
    PG8_WAIT_V(0);
    PG8_BAR;
#undef PG8_SA
#undef PG8_SB
#undef PG8_STAGE
#undef PG8_ASTAGE
#undef PG8_LDA
#undef PG8_LDB
#undef PG8_MMA
#undef PG8_WAIT_V
#undef PG8_WAIT_L
#undef PG8_BAR
#undef PG8_SCHED
}
}

struct Ctx {
    LAS unsigned char* lds; int tid, lane, wave, G, bid;
    const float *x, *c, *w_ada, *b_ada, *g_pre_mix, *g_post_mix, *w_in, *attn_norm_w, *hgrn_lb, *hgrn_norm_w, *w_out, *g_pre_ffn, *g_post_ffn, *w_router, *b_router, *w_gu, *b_gu, *w_down, *b_down;
    float* out; unsigned char* ws;
};
#define LDS_FENCE() asm volatile("s_waitcnt lgkmcnt(0)" ::: "memory")

__device__ __forceinline__ void p0_transpose_item(const float* W, int N, int k0, int n0, bf16_t* dst_row0, LAS float* scr, int lane) {
    const int q = lane & 7, kr = lane >> 3;
    f32x4 v[8];
#pragma unroll
    for (int i = 0; i < 8; ++i) v[i] = *(const f32x4*)(W + (size_t)(k0 + 8 * i + kr) * N + n0 + 4 * q);
#pragma unroll
    for (int i = 0; i < 8; ++i) { const int k = 8 * i + kr;
        scr[(4 * q + 0) * 65 + k] = v[i].x; scr[(4 * q + 1) * 65 + k] = v[i].y; scr[(4 * q + 2) * 65 + k] = v[i].z; scr[(4 * q + 3) * 65 + k] = v[i].w; }
    LDS_FENCE();
    const int c = lane & 7;
#pragma unroll
    for (int j = 0; j < 4; ++j) { const int n = (lane >> 3) + 8 * j; const LAS float* s = scr + n * 65 + 8 * c;
        u32x4 o; o.x = pk2(s[0], s[1]); o.y = pk2(s[2], s[3]); o.z = pk2(s[4], s[5]); o.w = pk2(s[6], s[7]);
        *(u32x4*)(dst_row0 + (size_t)n * 1024 + k0 + 8 * c) = o; }
    LDS_FENCE();
}
__device__ __forceinline__ void p0_prologue(Ctx& F) {
    {
        LAS float* cond = (LAS float*)F.lds; LAS float* red = cond + 4096;
        for (int i = F.tid; i < 4096; i += 512) { const float v = F.c[i]; cond[i] = v * sigmoidf_(v); }
        __syncthreads();
        float* mod = (float*)(F.ws + WS_MOD);
        for (int u = F.bid; u < 192; u += F.G) {
            const int n0 = u * 32, q = F.tid & 7, kg = F.tid >> 3;
            f32x4 a0 = {0.f, 0.f, 0.f, 0.f}, a1 = a0, a2 = a0, a3 = a0;
#pragma unroll 4
            for (int i = 0; i < 16; ++i) { const int k = kg + 64 * i; const f32x4 w = *(const f32x4*)(F.w_ada + (size_t)k * 6144 + n0 + 4 * q);
                a0 += w * cond[k]; a1 += w * cond[1024 + k]; a2 += w * cond[2048 + k]; a3 += w * cond[3072 + k]; }
            *(LAS f32x4*)(red + kg * 128 + 0 + 4 * q) = a0; *(LAS f32x4*)(red + kg * 128 + 32 + 4 * q) = a1;
            *(LAS f32x4*)(red + kg * 128 + 64 + 4 * q) = a2; *(LAS f32x4*)(red + kg * 128 + 96 + 4 * q) = a3;
            __syncthreads();
            if (F.tid < 128) { float s = 0.f;
                for (int g = 0; g < 64; ++g) s += red[g * 128 + F.tid];
                const int b = F.tid >> 5, col = F.tid & 31; mod[b * 6144 + n0 + col] = s + F.b_ada[n0 + col]; }
            __syncthreads();
        }
        __syncthreads();
    }
    LAS float* scr = (LAS float*)F.lds + F.wave * 2080;
    const int gw = F.bid * 8 + F.wave, NGW = F.G * 8;
    constexpr int I_IN = 16 * 112, I_OUT = 16 * 32, I_GU = 32 * 16 * 64, I_DN = 32 * 16 * 32, NITEMS = I_IN + I_OUT + I_GU + I_DN;
    for (int it = gw; it < NITEMS; it += NGW) {
        int r = it;
        if (r < I_IN) { const int kb = r / 112, nb = r % 112; p0_transpose_item(F.w_in, DIN, kb * 64, nb * 32, (bf16_t*)(F.ws + WS_WIN) + (size_t)(nb * 32) * 1024, scr, F.lane); continue; } r -= I_IN;
        if (r < I_OUT) { const int kb = r / 32, nb = r % 32; p0_transpose_item(F.w_out, D, kb * 64, nb * 32, (bf16_t*)(F.ws + WS_WOUT) + (size_t)(nb * 32) * 1024, scr, F.lane); continue; } r -= I_OUT;
        if (r < I_GU) { const int e = r / 1024, r2 = r % 1024, kb = r2 / 64, nb = r2 % 64; const int n0 = nb * 32;
            const int drow = (n0 < 1024) ? ((n0 >> 7) * 256 + (n0 & 127)) : (((n0 - 1024) >> 7) * 256 + 128 + ((n0 - 1024) & 127));
            p0_transpose_item(F.w_gu + (size_t)e * 1024 * 2048, 2048, kb * 64, n0, (bf16_t*)(F.ws + WS_WGU) + ((size_t)e * 2048 + drow) * 1024, scr, F.lane); continue; } r -= I_GU;
        { const int e = r / 512, r2 = r % 512, kb = r2 / 32, nb = r2 % 32;
            p0_transpose_item(F.w_down + (size_t)e * 1024 * 1024, 1024, kb * 64, nb * 32, (bf16_t*)(F.ws + WS_WDN) + ((size_t)e * 1024 + nb * 32) * 1024, scr, F.lane); }
    }
}

__device__ __forceinline__ void p1_norm_mod(Ctx& F) {
    const int gw = F.bid * 8 + F.wave, NGW = F.G * 8;
    const float* mod = (const float*)(F.ws + WS_MOD);
    bf16_t* H = (bf16_t*)(F.ws + WS_H);
    for (int m = gw; m < T; m += NGW) {
        const int b = m / SEQ;
        const f32x4* xr = (const f32x4*)(F.x + (size_t)m * D) + F.lane;
        f32x4 v[4]; float ss = 0.f;
#pragma unroll
        for (int j = 0; j < 4; ++j) { v[j] = xr[64 * j]; ss += (v[j].x * v[j].x + v[j].y * v[j].y) + (v[j].z * v[j].z + v[j].w * v[j].w); }
        const float rstd = 1.0f / sqrtf(wave_sum(ss) * (1.f / D) + EPS);
        u32x2* o = (u32x2*)(H + (size_t)m * D) + F.lane;
#pragma unroll
        for (int j = 0; j < 4; ++j) { const int k = 4 * F.lane + 256 * j;
            const f32x4 g = *(const f32x4*)(F.g_pre_mix + k), sh = *(const f32x4*)(mod + b * 6144 + k), sc = *(const f32x4*)(mod + b * 6144 + 1024 + k);
            const f32x4 h = v[j] * rstd * g * (sc + 1.0f) + sh;
            u32x2 w; w.x = pk2(h.x, h.y); w.y = pk2(h.z, h.w); o[64 * j] = w; }
    }
}

constexpr int HG_QE = 0, HG_KE = 8704, HG_KD = 17408, HG_V = 27648, HG_SEG = 37888, HG_DEC = 41984, HG_OP = 42496;
__device__ __forceinline__ void hgrn_local_unit(Ctx& F, int u) {
    const int bh = u >> 4, jj = u & 15, b = bh >> 2, h = bh & 3;
    const int rowbase = b * SEQ + jj * 256;
    const bf16_t* proj = (const bf16_t*)(F.ws + WS_PROJ);
    bf16_t* QE = (bf16_t*)(F.ws + WS_QE); bf16_t* OLOC = (bf16_t*)(F.ws + WS_OLOC);
    LAS unsigned char* L = F.lds;
    const int seg = F.wave, dp = F.lane;
    const int eb = F.wave & 3, dh = F.wave >> 2, c32 = F.lane & 31, hh = F.lane >> 5;
    const int i16 = F.lane & 15, tq = i16 >> 2, tp = i16 & 3, blk = (F.lane >> 4) & 1;
    float lbv[2], oml[2], ecum[2] = {1.f, 1.f};
#pragma unroll
    for (int dd = 0; dd < 2; ++dd) { const int d = h * 128 + 2 * dp + dd; const float a0 = F.hgrn_lb[d], a1 = F.hgrn_lb[512 + d]; lbv[dd] = 1.f / (1.f + __expf(a1 - a0)); oml[dd] = 1.f - lbv[dd]; }
    f32x16 Sacc[2];
#pragma unroll
    for (int i = 0; i < 2; ++i)
#pragma unroll
        for (int r = 0; r < 16; ++r) Sacc[i][r] = 0.f;
    LAS float* segtot = (LAS float*)(L + HG_SEG); LAS float* dec = (LAS float*)(L + HG_DEC); LAS float* op = (LAS float*)(L + HG_OP);
    for (int sc = 0; sc < 8; ++sc) {
        const int row0 = rowbase + sc * 32;
        unsigned fr2[4], qr2[4], v2[4];
#pragma unroll
        for (int i = 0; i < 4; ++i) { const bf16_t* rp = proj + (size_t)(row0 + 4 * seg + i) * DIN + h * 128 + 2 * dp;
            fr2[i] = *(const unsigned*)(rp + C_FR); qr2[i] = *(const unsigned*)(rp + C_QR); v2[i] = *(const unsigned*)(rp + C_IR); }
        float Pc[4][2], kk[4][2], qq[4][2], run[2] = {1.f, 1.f};
#pragma unroll
        for (int i = 0; i < 4; ++i)
#pragma unroll
            for (int dd = 0; dd < 2; ++dd) {
                const float fr = dd ? bfhi(fr2[i]) : bflo(fr2[i]); const float qr = dd ? bfhi(qr2[i]) : bflo(qr2[i]);
                const float sg = sigmoidf_(fr); const float f = lbv[dd] + oml[dd] * sg;
                kk[i][dd] = oml[dd] * (1.f - sg); run[dd] *= f; Pc[i][dd] = run[dd]; qq[i][dd] = qr * sigmoidf_(qr); }
        *(LAS f32x2*)(segtot + seg * 128 + 2 * dp) = (f32x2){run[0], run[1]};
        __syncthreads();
        float pre[2] = {1.f, 1.f}, tot[2] = {1.f, 1.f};
#pragma unroll
        for (int s = 0; s < 8; ++s) { const f32x2 t2 = *(const LAS f32x2*)(segtot + s * 128 + 2 * dp);
            pre[0] *= (s < seg) ? t2.x : 1.f; pre[1] *= (s < seg) ? t2.y : 1.f; tot[0] *= t2.x; tot[1] *= t2.y; }
#pragma unroll
        for (int i = 0; i < 4; ++i) { const int trow = 4 * seg + i; float qe[2], ke[2], kd[2];
#pragma unroll
            for (int dd = 0; dd < 2; ++dd) { const float Eb = pre[dd] * Pc[i][dd]; const float inv = 1.f / Eb; qe[dd] = qq[i][dd] * Eb; ke[dd] = kk[i][dd] * inv; kd[dd] = ke[dd] * tot[dd]; }
            *(LAS unsigned*)(L + HG_QE + trow * 272 + 4 * dp) = pk2(qe[0], qe[1]);
            *(LAS unsigned*)(L + HG_KE + trow * 272 + 4 * dp) = pk2(ke[0], ke[1]);
            *(LAS unsigned*)(L + HG_KD + trow * 320 + 4 * dp) = pk2(kd[0], kd[1]);
            *(LAS unsigned*)(L + HG_V + trow * 320 + 4 * dp) = v2[i];
            *(unsigned*)(QE + (size_t)(row0 + trow) * 512 + h * 128 + 2 * dp) = pk2(qe[0] * ecum[0], qe[1] * ecum[1]); }
        if (seg == 0) *(LAS f32x2*)(dec + 2 * dp) = (f32x2){tot[0], tot[1]};
        ecum[0] *= tot[0]; ecum[1] *= tot[1];
        __syncthreads();
        f32x16 X;
#pragma unroll
        for (int r = 0; r < 16; ++r) X[r] = 0.f;
#pragma unroll
        for (int k = 0; k < 4; ++k) { const int dofs = (64 * dh + 16 * k + 8 * hh) * 2;
            const bf16x8 a = *(const LAS bf16x8*)(L + HG_KE + c32 * 272 + dofs); const bf16x8 bq = *(const LAS bf16x8*)(L + HG_QE + c32 * 272 + dofs);
            X = MFMA32(a, bq, X); }
#pragma unroll
        for (int r = 0; r < 16; ++r) X[r] = (crow(r, hh) <= c32) ? X[r] : 0.f;
        f32x16 O;
#pragma unroll
        for (int r = 0; r < 16; ++r) O[r] = 0.f;
#pragma unroll
        for (int s2 = 0; s2 < 2; ++s2) { const LAS unsigned char* vb = L + HG_V + (16 * s2 + 4 * hh + tq) * 320 + (32 * eb + 16 * blk + 4 * tp) * 2;
            const bf16x8 a2 = cat8(tr_read(vb), tr_read(vb + 8 * 320)); O = MFMA32(a2, pack_step(X, s2), O); }
#pragma unroll
        for (int i = 0; i < 2; ++i)
#pragma unroll
            for (int s3 = 0; s3 < 2; ++s3) { const LAS unsigned char* qb = L + HG_QE + c32 * 272 + (32 * (2 * dh + i) + 16 * s3 + 4 * hh) * 2;
                const s16x4 lo = *(const LAS s16x4*)qb, hi = *(const LAS s16x4*)(qb + 16);
                O = MFMA32(pack_step(Sacc[i], s3), cat8(lo, hi), O); }
#pragma unroll
        for (int i = 0; i < 2; ++i) { const int dblk = 2 * dh + i;
#pragma unroll
            for (int r = 0; r < 16; ++r) Sacc[i][r] *= dec[32 * dblk + crow(r, hh)];
#pragma unroll
            for (int st = 0; st < 2; ++st) { const LAS unsigned char* ka = L + HG_KD + (16 * st + 8 * hh + tq) * 320 + (32 * dblk + 16 * blk + 4 * tp) * 2;
                const LAS unsigned char* va = L + HG_V + (16 * st + 8 * hh + tq) * 320 + (32 * eb + 16 * blk + 4 * tp) * 2;
                const bf16x8 a4 = cat8(tr_read(ka), tr_read(ka + 4 * 320)); const bf16x8 b4 = cat8(tr_read(va), tr_read(va + 4 * 320));
                Sacc[i] = MFMA32(a4, b4, Sacc[i]); } }
        if (dh == 1) {
#pragma unroll
            for (int r = 0; r < 16; ++r) op[(eb * 16 + r) * 64 + F.lane] = O[r]; }
        __syncthreads();
        if (dh == 0) {
#pragma unroll
            for (int r = 0; r < 16; ++r) O[r] += op[(eb * 16 + r) * 64 + F.lane];
            bf16_t* orow = OLOC + (size_t)(row0 + c32) * 512 + h * 128 + 32 * eb + 4 * hh;
#pragma unroll
            for (int g = 0; g < 4; ++g) { u32x2 w; w.x = pk2(O[4 * g], O[4 * g + 1]); w.y = pk2(O[4 * g + 2], O[4 * g + 3]); *(u32x2*)(orow + 8 * g) = w; } }
    }
    float* SL = (float*)(F.ws + WS_SLOC) + (size_t)u * 16384;
#pragma unroll
    for (int i = 0; i < 2; ++i)
#pragma unroll
        for (int r = 0; r < 16; ++r) SL[(32 * (2 * dh + i) + crow(r, hh)) * 128 + 32 * eb + c32] = Sacc[i][r];
    if (seg == 0) *(f32x2*)((float*)(F.ws + WS_DTOT) + u * 128 + 2 * dp) = (f32x2){ecum[0], ecum[1]};
    __syncthreads();
}

constexpr int AT_KS = 144, AT_VS = 192, AT_K = 0, AT_V = 384 * 144;
__device__ __forceinline__ void attn_unit(Ctx& F, int u) {
    const int n = u >> 9, rem = u & 511;
    int dil, r, p; const int bh = rem >> 4;
    if (n == 0) { dil = 1; p = rem & 15; r = 0; } else if (n == 1) { dil = 4; r = (rem >> 2) & 3; p = rem & 3; } else { dil = 16; r = rem & 15; p = 0; }
    const int b = bh >> 3, h = bh & 7;
    const bf16_t* proj = (const bf16_t*)(F.ws + WS_PROJ);
    LAS unsigned char* L = F.lds;
    const int w = F.wave, c32 = F.lane & 31, hh = F.lane >> 5;
    const int i16 = F.lane & 15, tq = i16 >> 2, tp = i16 & 3, blk = (F.lane >> 4) & 1;
    {
        u32x4 kv[12];
#pragma unroll
        for (int it = 0; it < 12; ++it) { const int idx = F.tid + 512 * (it % 6); const int row = idx >> 3, pc = idx & 7; const int sub = 256 * p - 128 + row;
            const int subc = sub < 0 ? 0 : sub;
            const bf16_t* src = proj + (size_t)(b * SEQ + subc * dil + r) * DIN + (it < 6 ? C_KA : C_VA) + h * 64 + pc * 8;
            kv[it] = *(const u32x4*)src; if (sub < 0) kv[it] = (u32x4){0u, 0u, 0u, 0u}; }
#pragma unroll
        for (int it = 0; it < 12; ++it) { const int idx = F.tid + 512 * (it % 6); const int row = idx >> 3, pc = idx & 7;
            if (it < 6) *(LAS u32x4*)(L + AT_K + row * AT_KS + pc * 16) = kv[it]; else *(LAS u32x4*)(L + AT_V + row * AT_VS + pc * 16) = kv[it]; }
    }
    const int qsub = 256 * p + 32 * w + c32; const size_t grow = (size_t)b * SEQ + (size_t)qsub * dil + r;
    bf16x8 qf[4];
#pragma unroll
    for (int k = 0; k < 4; ++k) qf[k] = *(const bf16x8*)(proj + grow * DIN + C_QA + h * 64 + 16 * k + 8 * hh);
    __syncthreads();
    const int kb0 = (p == 0 && w < 4) ? (4 - w) : 0;
    f32x16 X[5];
#pragma unroll
    for (int kb = 0; kb < 5; ++kb) {
#pragma unroll
        for (int r16 = 0; r16 < 16; ++r16) X[kb][r16] = 0.f;
        if (kb >= kb0) {
#pragma unroll
            for (int k = 0; k < 4; ++k) { const bf16x8 a = *(const LAS bf16x8*)(L + AT_K + (32 * (w + kb) + c32) * AT_KS + (16 * k + 8 * hh) * 2); X[kb] = MFMA32(a, qf[k], X[kb]); } }
    }
    float m = -INFINITY;
#pragma unroll
    for (int kb = 0; kb < 5; ++kb)
#pragma unroll
        for (int r16 = 0; r16 < 16; ++r16) { const int row = crow(r16, hh);
            bool valid = (kb >= kb0); if (kb == 0) valid = valid && (row >= c32); if (kb == 4) valid = valid && (row <= c32);
            X[kb][r16] = valid ? X[kb][r16] : -INFINITY; m = fmaxf(m, X[kb][r16]); }
    m = fmaxf(m, __shfl_xor(m, 32));
    const float c2 = 0.125f * 1.4426950408889634f;
    float l = 0.f;
#pragma unroll
    for (int kb = 0; kb < 5; ++kb)
#pragma unroll
        for (int r16 = 0; r16 < 16; ++r16) { const float pv = exp2f((X[kb][r16] - m) * c2); X[kb][r16] = pv; l += pv; }
    l += __shfl_xor(l, 32);
    f32x16 O[2];
#pragma unroll
    for (int i = 0; i < 2; ++i)
#pragma unroll
        for (int r16 = 0; r16 < 16; ++r16) O[i][r16] = 0.f;
#pragma unroll
    for (int kb = 0; kb < 5; ++kb) {
        if (kb >= kb0) {
#pragma unroll
            for (int s = 0; s < 2; ++s) { const bf16x8 pb = pack_step(X[kb], s);
#pragma unroll
                for (int dhf = 0; dhf < 2; ++dhf) { const LAS unsigned char* vb = L + AT_V + (32 * (w + kb) + 16 * s + 4 * hh + tq) * AT_VS + (32 * dhf + 16 * blk + 4 * tp) * 2;
                    const bf16x8 a = cat8(tr_read(vb), tr_read(vb + 8 * AT_VS)); O[dhf] = MFMA32(a, pb, O[dhf]); } } }
    }
    const float inv = 1.f / l;
    bf16_t* po = (bf16_t*)(F.ws + WS_PARTO) + ((size_t)n * T + grow) * 512 + h * 64 + 4 * hh;
#pragma unroll
    for (int dhf = 0; dhf < 2; ++dhf)
#pragma unroll
        for (int g = 0; g < 4; ++g) { u32x2 wv; wv.x = pk2(O[dhf][4 * g] * inv, O[dhf][4 * g + 1] * inv); wv.y = pk2(O[dhf][4 * g + 2] * inv, O[dhf][4 * g + 3] * inv);
            *(u32x2*)(po + 32 * dhf + 8 * g) = wv; }
    if (hh == 0) ((float*)(F.ws + WS_LSE))[((size_t)n * T + grow) * 8 + h] = m * 0.125f + __logf(l);
    __syncthreads();
}

__device__ __forceinline__ void p4_scan(Ctx& F) {
    const float* SL = (const float*)(F.ws + WS_SLOC); const float* DT = (const float*)(F.ws + WS_DTOT); bf16_t* SIN = (bf16_t*)(F.ws + WS_SIN);
    for (int unit = F.bid; unit < 256; unit += F.G) {
        const int bh = unit >> 4, bk = unit & 15, db = bk >> 2, ebk = bk & 3;
        const int e = 32 * ebk + (F.tid & 31), d0 = 32 * db + (F.tid >> 5), d1 = d0 + 16;
        float s0 = 0.f, s1 = 0.f;
        for (int j = 0; j < 16; ++j) { const int u = bh * 16 + j;
            SIN[(size_t)u * 16384 + d0 * 128 + e] = (bf16_t)(pk2(s0, 0.f) & 0xffffu); SIN[(size_t)u * 16384 + d1 * 128 + e] = (bf16_t)(pk2(s1, 0.f) & 0xffffu);
            s0 = DT[u * 128 + d0] * s0 + SL[(size_t)u * 16384 + d0 * 128 + e]; s1 = DT[u * 128 + d1] * s1 + SL[(size_t)u * 16384 + d1 * 128 + e]; }
    }
}

__device__ __forceinline__ void p5_fixup_unit(Ctx& F, int u) {
    const int bh = u >> 4, jj = u & 15, b = bh >> 2, h = bh & 3;
    const int rowbase = b * SEQ + jj * 256;
    LAS unsigned char* L = F.lds;
    const bf16_t* SIN = (const bf16_t*)(F.ws + WS_SIN) + (size_t)u * 16384;
    const bf16_t* QE = (const bf16_t*)(F.ws + WS_QE); const bf16_t* OLOC = (const bf16_t*)(F.ws + WS_OLOC); const bf16_t* proj = (const bf16_t*)(F.ws + WS_PROJ);
    bf16_t* YC = (bf16_t*)(F.ws + WS_YCAT);
    const int c32 = F.lane & 31, hh = F.lane >> 5, i16 = F.lane & 15, tq = i16 >> 2, tp = i16 & 3, blk = (F.lane >> 4) & 1;
#pragma unroll
    for (int it = 0; it < 4; ++it) { const int idx = F.tid + 512 * it, row = idx >> 4, pc = idx & 15; *(LAS u32x4*)(L + row * 320 + pc * 16) = *(const u32x4*)(SIN + row * 128 + pc * 8); }
    const size_t tok = (size_t)rowbase + 32 * F.wave + c32;
    bf16x8 bq[8];
#pragma unroll
    for (int k = 0; k < 8; ++k) bq[k] = *(const bf16x8*)(QE + tok * 512 + h * 128 + 16 * k + 8 * hh);
    __syncthreads();
    f32x16 acc[4];
#pragma unroll
    for (int et = 0; et < 4; ++et) {
#pragma unroll
        for (int r = 0; r < 16; ++r) acc[et][r] = 0.f;
#pragma unroll
        for (int k = 0; k < 8; ++k) { const LAS unsigned char* sb = L + (16 * k + 8 * hh + tq) * 320 + (32 * et + 16 * blk + 4 * tp) * 2;
            const bf16x8 a = cat8(tr_read(sb), tr_read(sb + 4 * 320)); acc[et] = MFMA32(a, bq[k], acc[et]); }
    }
    float ss = 0.f;
#pragma unroll
    for (int et = 0; et < 4; ++et)
#pragma unroll
        for (int g = 0; g < 4; ++g) { const int e0 = 32 * et + 8 * g + 4 * hh; const u32x2 ol = *(const u32x2*)(OLOC + tok * 512 + h * 128 + e0);
            acc[et][4 * g] += bflo(ol.x); acc[et][4 * g + 1] += bfhi(ol.x); acc[et][4 * g + 2] += bflo(ol.y); acc[et][4 * g + 3] += bfhi(ol.y);
            ss += (acc[et][4 * g] * acc[et][4 * g] + acc[et][4 * g + 1] * acc[et][4 * g + 1]) + (acc[et][4 * g + 2] * acc[et][4 * g + 2] + acc[et][4 * g + 3] * acc[et][4 * g + 3]); }
    ss += __shfl_xor(ss, 32);
    const float rstd = 1.0f / sqrtf(ss * (1.f / 128.f) + EPS);
#pragma unroll
    for (int et = 0; et < 4; ++et)
#pragma unroll
        for (int g = 0; g < 4; ++g) { const int e0 = 32 * et + 8 * g + 4 * hh; const f32x4 nw = *(const f32x4*)(F.hgrn_norm_w + h * 128 + e0);
            const u32x2 g2 = *(const u32x2*)(proj + tok * DIN + C_GR + h * 128 + e0);
            const float ga = bflo(g2.x), gb = bfhi(g2.x), gc = bflo(g2.y), gd = bfhi(g2.y);
            u32x2 wv; wv.x = pk2(acc[et][4 * g] * rstd * nw.x * (ga * sigmoidf_(ga)), acc[et][4 * g + 1] * rstd * nw.y * (gb * sigmoidf_(gb)));
            wv.y = pk2(acc[et][4 * g + 2] * rstd * nw.z * (gc * sigmoidf_(gc)), acc[et][4 * g + 3] * rstd * nw.w * (gd * sigmoidf_(gd)));
            *(u32x2*)(YC + tok * 1024 + 512 + h * 128 + e0) = wv; }
    __syncthreads();
}
__device__ __forceinline__ void p5_attn_merge(Ctx& F) {
    const int gw = F.bid * 8 + F.wave, NGW = F.G * 8;
    const bf16_t* PO = (const bf16_t*)(F.ws + WS_PARTO); const float* LS = (const float*)(F.ws + WS_LSE); bf16_t* YC = (bf16_t*)(F.ws + WS_YCAT);
    const int hd = F.lane >> 3, sub = F.lane & 7;
    for (int tok = gw; tok < T; tok += NGW) {
        float ls[3]; u32x4 o[3];
#pragma unroll
        for (int n = 0; n < 3; ++n) { ls[n] = LS[((size_t)n * T + tok) * 8 + hd]; o[n] = *(const u32x4*)(PO + ((size_t)n * T + tok) * 512 + hd * 64 + sub * 8); }
        const float mx = fmaxf(ls[0], fmaxf(ls[1], ls[2]));
        float wgt[3]; wgt[0] = __expf(ls[0] - mx); wgt[1] = __expf(ls[1] - mx); wgt[2] = __expf(ls[2] - mx);
        const float inv = 1.f / (wgt[0] + wgt[1] + wgt[2]);
        float v[8];
#pragma unroll
        for (int i = 0; i < 8; ++i) v[i] = 0.f;
#pragma unroll
        for (int n = 0; n < 3; ++n) { const float wn = wgt[n] * inv;
            v[0] += wn * bflo(o[n].x); v[1] += wn * bfhi(o[n].x); v[2] += wn * bflo(o[n].y); v[3] += wn * bfhi(o[n].y);
            v[4] += wn * bflo(o[n].z); v[5] += wn * bfhi(o[n].z); v[6] += wn * bflo(o[n].w); v[7] += wn * bfhi(o[n].w); }
        float ss = 0.f;
#pragma unroll
        for (int i = 0; i < 8; ++i) ss += v[i] * v[i];
        ss += __shfl_xor(ss, 1); ss += __shfl_xor(ss, 2); ss += __shfl_xor(ss, 4);
        const float rstd = 1.0f / sqrtf(ss * (1.f / 64.f) + EPS);
        const f32x4 n0 = *(const f32x4*)(F.attn_norm_w + hd * 64 + sub * 8), n1 = *(const f32x4*)(F.attn_norm_w + hd * 64 + sub * 8 + 4);
        u32x4 wv; wv.x = pk2(v[0] * rstd * n0.x, v[1] * rstd * n0.y); wv.y = pk2(v[2] * rstd * n0.z, v[3] * rstd * n0.w);
        wv.z = pk2(v[4] * rstd * n1.x, v[5] * rstd * n1.y); wv.w = pk2(v[6] * rstd * n1.z, v[7] * rstd * n1.w);
        *(u32x4*)(YC + (size_t)tok * 1024 + hd * 64 + sub * 8) = wv;
    }
}

__device__ __forceinline__ void p7_row(Ctx& F, int m, float (&hv)[16]) {
    const float* mod = (const float*)(F.ws + WS_MOD); const int b = m / SEQ;
    const f32x4* yr = (const f32x4*)((const float*)(F.ws + WS_Y) + (size_t)m * D) + F.lane;
    const f32x4* xr = (const f32x4*)(F.x + (size_t)m * D) + F.lane;
    f32x4 y[4], xv[4]; float ss = 0.f;
#pragma unroll
    for (int j = 0; j < 4; ++j) { y[j] = yr[64 * j]; xv[j] = xr[64 * j]; ss += (y[j].x * y[j].x + y[j].y * y[j].y) + (y[j].z * y[j].z + y[j].w * y[j].w); }
    const float rstd1 = 1.0f / sqrtf(wave_sum(ss) * (1.f / D) + EPS);
    f32x4* x2o = (f32x4*)((float*)(F.ws + WS_X2) + (size_t)m * D) + F.lane;
    float ss2 = 0.f;
#pragma unroll
    for (int j = 0; j < 4; ++j) { const int k = 4 * F.lane + 256 * j;
        const f32x4 gp = *(const f32x4*)(F.g_post_mix + k), gm = *(const f32x4*)(mod + b * 6144 + 2048 + k);
        xv[j] = xv[j] + gm * (y[j] * rstd1 * gp); x2o[64 * j] = xv[j];
        ss2 += (xv[j].x * xv[j].x + xv[j].y * xv[j].y) + (xv[j].z * xv[j].z + xv[j].w * xv[j].w); }
    const float rstd2 = 1.0f / sqrtf(wave_sum(ss2) * (1.f / D) + EPS);
    u32x2* ho = (u32x2*)((bf16_t*)(F.ws + WS_H) + (size_t)m * D) + F.lane;
#pragma unroll
    for (int j = 0; j < 4; ++j) { const int k = 4 * F.lane + 256 * j;
        const f32x4 g = *(const f32x4*)(F.g_pre_ffn + k), sh = *(const f32x4*)(mod + b * 6144 + 3072 + k), sc = *(const f32x4*)(mod + b * 6144 + 4096 + k);
        const f32x4 hx = xv[j] * rstd2 * g * (sc + 1.0f) + sh;
        u32x2 w; w.x = pk2(hx.x, hx.y); w.y = pk2(hx.z, hx.w); ho[64 * j] = w;
        hv[4 * j] = hx.x; hv[4 * j + 1] = hx.y; hv[4 * j + 2] = hx.z; hv[4 * j + 3] = hx.w; }
}
__device__ __forceinline__ void p7_select(Ctx& F, float (&lg)[32], int m, int mloc, LAS int* hist, LAS int* pbp, LAS int* pbe) {
    float val[4]; int idx[4];
#pragma unroll
    for (int kk = 0; kk < 4; ++kk) { float best = -INFINITY; int bi = 0;
#pragma unroll
        for (int e = 0; e < 32; ++e) { const bool gt = lg[e] > best; best = gt ? lg[e] : best; bi = gt ? e : bi; }
        val[kk] = best; idx[kk] = bi;
#pragma unroll
        for (int e = 0; e < 32; ++e) lg[e] = (e == bi) ? -INFINITY : lg[e]; }
    float g[4]; float s = 0.f;
#pragma unroll
    for (int kk = 0; kk < 4; ++kk) { g[kk] = __expf(val[kk] - val[0]); s += g[kk]; }
    const float inv = 1.f / s;
    if (F.lane == 0) {
        float* gate = (float*)(F.ws + WS_GATE);
#pragma unroll
        for (int kk = 0; kk < 4; ++kk) { const int rank = atomicAdd((int*)(hist + idx[kk]), 1); const int slot = mloc * 4 + kk;
            pbp[slot] = m * 4 + kk; pbe[slot] = idx[kk] | (rank << 8); gate[m * 4 + kk] = g[kk] * inv; }
    }
}
__device__ __forceinline__ void p7_rows(Ctx& F) {
    LAS unsigned char* wl = F.lds;
    LAS int* hist = (LAS int*)(F.lds + MISC_OFF); LAS int* gbase = hist + 32; LAS int* pbp = hist + 64; LAS int* pbe = hist + 64 + 256;
    unsigned* cnt = (unsigned*)(F.ws + WS_CTL) + CW_CNT; int* TOK = (int*)(F.ws + WS_TOK);
#pragma unroll
    for (int it = 0; it < 16; ++it) { const int ci = F.tid + 512 * it, k = ci >> 3, ch = ci & 7, pos = (k & 3) * 256 + (k >> 2);
        *(LAS f32x4*)(wl + pos * 128 + 16 * (ch ^ ((pos >> 1) & 7))) = *(const f32x4*)(F.w_router + k * 32 + 4 * ch); }
    const int sw = (F.lane >> 1) & 7;
    for (int rb = F.bid; rb < T / 64; rb += F.G) {
        if (F.tid < 32) hist[F.tid] = 0;
        __syncthreads();
        for (int pr = 0; pr < 4; ++pr) {
            const int mloc = F.wave * 8 + 2 * pr, m0 = rb * 64 + mloc;
            float ha[16], hb[16];
            p7_row(F, m0, ha); p7_row(F, m0 + 1, hb);
            float la[32], lb[32];
#pragma unroll
            for (int e = 0; e < 32; ++e) { la[e] = 0.f; lb[e] = 0.f; }
#pragma unroll
            for (int j = 0; j < 4; ++j)
#pragma unroll
                for (int i = 0; i < 4; ++i) { const LAS unsigned char* base = wl + (i * 256 + 64 * j + F.lane) * 128;
#pragma unroll
                    for (int ch = 0; ch < 8; ++ch) { const f32x4 w4 = *(const LAS f32x4*)(base + 16 * (ch ^ sw));
                        const float a = ha[4 * j + i], bb = hb[4 * j + i];
                        la[4 * ch] += a * w4.x; la[4 * ch + 1] += a * w4.y; la[4 * ch + 2] += a * w4.z; la[4 * ch + 3] += a * w4.w;
                        lb[4 * ch] += bb * w4.x; lb[4 * ch + 1] += bb * w4.y; lb[4 * ch + 2] += bb * w4.z; lb[4 * ch + 3] += bb * w4.w; } }
#pragma unroll
            for (int e = 0; e < 32; ++e) { la[e] = wave_sum(la[e]) + F.b_router[e]; lb[e] = wave_sum(lb[e]) + F.b_router[e]; }
            p7_select(F, la, m0, mloc, hist, pbp, pbe);
            p7_select(F, lb, m0 + 1, mloc + 1, hist, pbp, pbe);
        }
        __syncthreads();
        if (F.tid < 32) gbase[F.tid] = (int)atomicAdd(cnt + 64 * F.tid, (unsigned)hist[F.tid]);
        __syncthreads();
        if (F.tid < 256) { const int e = pbe[F.tid] & 255, rank = pbe[F.tid] >> 8; TOK[e * LIST_CAP + gbase[e] + rank] = pbp[F.tid]; }
        __syncthreads();
    }
}

__device__ __forceinline__ void moe_tables(Ctx& F, LAS int* cntl, LAS int* tbase, LAS int* tile_e) {
    const unsigned* cnt = (const unsigned*)(F.ws + WS_CTL) + CW_CNT;
    if (F.tid < NE) cntl[F.tid] = (int)__hip_atomic_load(cnt + 64 * F.tid, __ATOMIC_RELAXED, __HIP_MEMORY_SCOPE_AGENT);
    __syncthreads();
    if (F.tid <= NE) { int base = 0;
        for (int e = 0; e < F.tid; ++e) base += (cntl[e] + 255) >> 8;
        tbase[F.tid] = base; }
    __syncthreads();
    if (F.tid < 320) { int e = 0;
        for (int q = 1; q < NE; ++q) e = (tbase[q] <= F.tid) ? q : e;
        tile_e[F.tid] = e; }
    __syncthreads();
}

__device__ __forceinline__ void p10_final(Ctx& F) {
    const int gw = F.bid * 8 + F.wave, NGW = F.G * 8;
    const float* mod = (const float*)(F.ws + WS_MOD); const bf16_t* YP = (const bf16_t*)(F.ws + WS_YPAIR); const float* X2 = (const float*)(F.ws + WS_X2);
    for (int m = gw; m < T; m += NGW) {
        const int b = m / SEQ;
        f32x4 y[4]; float ss = 0.f;
#pragma unroll
        for (int j = 0; j < 4; ++j) { y[j] = (f32x4){0.f, 0.f, 0.f, 0.f};
#pragma unroll
            for (int kk = 0; kk < 4; ++kk) { const u32x2 v = *((const u32x2*)(YP + ((size_t)m * 4 + kk) * 1024) + F.lane + 64 * j);
                y[j].x += bflo(v.x); y[j].y += bfhi(v.x); y[j].z += bflo(v.y); y[j].w += bfhi(v.y); }
            ss += (y[j].x * y[j].x + y[j].y * y[j].y) + (y[j].z * y[j].z + y[j].w * y[j].w); }
        const float rstd = 1.0f / sqrtf(wave_sum(ss) * (1.f / D) + EPS);
        const f32x4* xr = (const f32x4*)(X2 + (size_t)m * D) + F.lane; f32x4* o = (f32x4*)(F.out + (size_t)m * D) + F.lane;
#pragma unroll
        for (int j = 0; j < 4; ++j) { const int k = 4 * F.lane + 256 * j;
            const f32x4 gp = *(const f32x4*)(F.g_post_ffn + k), gf = *(const f32x4*)(mod + b * 6144 + 5120 + k);
            o[64 * j] = xr[64 * j] + gf * (y[j] * rstd * gp); }
    }
}

struct Args { const float* in[19]; float* out; unsigned char* ws; int ph_lo, ph_hi; };
__global__ void __launch_bounds__(512, 2) fwd(Args args) {
    extern __shared__ __attribute__((aligned(16))) unsigned char lds_raw[];
    Ctx F;
    F.lds = (LAS unsigned char*)lds_raw;
    F.tid = threadIdx.x; F.lane = F.tid & 63; F.wave = __builtin_amdgcn_readfirstlane(F.tid >> 6); F.G = gridDim.x; F.bid = blockIdx.x;
    F.x = args.in[0]; F.c = args.in[1]; F.w_ada = args.in[2]; F.b_ada = args.in[3]; F.g_pre_mix = args.in[4]; F.g_post_mix = args.in[5]; F.w_in = args.in[6];
    F.attn_norm_w = args.in[7]; F.hgrn_lb = args.in[8]; F.hgrn_norm_w = args.in[9]; F.w_out = args.in[10]; F.g_pre_ffn = args.in[11]; F.g_post_ffn = args.in[12];
    F.w_router = args.in[13]; F.b_router = args.in[14]; F.w_gu = args.in[15]; F.b_gu = args.in[16]; F.w_down = args.in[17]; F.b_down = args.in[18];
    F.out = args.out; F.ws = args.ws;
    volatile LAS unsigned* barw = (volatile LAS unsigned*)(F.lds + BARW_OFF);
    if (F.tid < 4) barw[F.tid] = 0u;
    __syncthreads();
    XcdBarrier bar; bar.bar = (unsigned*)(F.ws + WS_CTL) + CW_BAR; bar.x = 0; bar.st = barw;
    if (MK_N_LAUNCHES == 1) bar = xcd_barrier_post((unsigned*)(F.ws + WS_CTL) + CW_BAR, barw);
    const int lo = args.ph_lo, hi = args.ph_hi;
#ifndef PH_MASK
#define PH_MASK 0x7ff
#endif
#define IN(k) ((((PH_MASK) >> (k)) & 1) && lo <= (k) && (k) < hi)
#define SEAM(k) do { if (IN(k) && IN((k) + 1)) xcd_barrier(bar); } while (0)

    if (IN(0)) { p0_prologue(F); } SEAM(0);
    if (IN(1)) { p1_norm_mod(F); } SEAM(1);
    if (IN(2)) {
        pg8::ProbPlain P{(const bf16_t*)(F.ws + WS_H), (const bf16_t*)(F.ws + WS_WIN)}; pg8::StaticOrder S; S.init(T, DIN, F.G, F.bid);
        pg8::EpiBf16 E{(bf16_t*)(F.ws + WS_PROJ), DIN};
        pg8::gemm_phase<pg8::EpiBf16, pg8::StaticOrder, pg8::ProbPlain>(F.lds, P, S, E);
    } SEAM(2);
    if (IN(3)) {
        for (int u = F.bid; u < 256; u += F.G) hgrn_local_unit(F, u);
        for (int u = F.bid; u < 1536; u += F.G) attn_unit(F, u);
    } SEAM(3);
    if (IN(4)) { p4_scan(F); } SEAM(4);
    if (IN(5)) {
        for (int u = F.bid; u < 256; u += F.G) p5_fixup_unit(F, u);
        p5_attn_merge(F);
    } SEAM(5);
    if (IN(6)) {
        pg8::ProbPlain P{(const bf16_t*)(F.ws + WS_YCAT), (const bf16_t*)(F.ws + WS_WOUT)}; pg8::StaticOrder S; S.init(T, D, F.G, F.bid);
        pg8::EpiF32 E{(float*)(F.ws + WS_Y), D};
        pg8::gemm_phase<pg8::EpiF32, pg8::StaticOrder, pg8::ProbPlain>(F.lds, P, S, E);
    } SEAM(6);
    if (IN(7)) { p7_rows(F); } SEAM(7);
    if (IN(8)) {
        LAS int* cntl = (LAS int*)(F.lds + MISC_OFF); LAS int* tbase = cntl + 32; LAS int* tile_e = cntl + 128;
        moe_tables(F, cntl, tbase, tile_e);
        pg8::ProbGU P{(const bf16_t*)(F.ws + WS_H), (const bf16_t*)(F.ws + WS_WGU), (const int*)(F.ws + WS_TOK)};
        pg8::MoeOrder S{cntl, tbase, tile_e, 8, F.G, F.bid};
        pg8::EpiGU E{(bf16_t*)(F.ws + WS_ACT), F.b_gu};
        pg8::gemm_phase<pg8::EpiGU, pg8::MoeOrder, pg8::ProbGU>(F.lds, P, S, E);
    } SEAM(8);
    if (IN(9)) {
        LAS int* cntl = (LAS int*)(F.lds + MISC_OFF); LAS int* tbase = cntl + 32; LAS int* tile_e = cntl + 128;
        moe_tables(F, cntl, tbase, tile_e);
        pg8::ProbDown P{(const bf16_t*)(F.ws + WS_ACT), (const bf16_t*)(F.ws + WS_WDN)};
        pg8::MoeOrder S{cntl, tbase, tile_e, 4, F.G, F.bid};
        pg8::EpiDown E{(bf16_t*)(F.ws + WS_YPAIR), F.b_down, (const float*)(F.ws + WS_GATE), (const int*)(F.ws + WS_TOK)};
        pg8::gemm_phase<pg8::EpiDown, pg8::MoeOrder, pg8::ProbDown>(F.lds, P, S, E);
    } SEAM(9);
    if (IN(10)) { p10_final(F); }
#undef IN
#undef SEAM
}

extern "C" void kernel_launch(void* const* d_in, const int* in_sizes, int n_in, void* d_out, int out_size, void* d_ws, size_t ws_size, hipStream_t stream) {
    static int grid = 0;
    if (grid == 0) {
        if (n_in != 19 || out_size != T * D || ws_size < WS_END) { fprintf(stderr, "kernel_launch: unexpected problem (n_in %d, out %d, ws %zu)\n", n_in, out_size, ws_size); grid = -1; return; }
        int dev = 0, cus = 0, per_cu = 0;
        if (hipGetDevice(&dev) != hipSuccess || hipDeviceGetAttribute(&cus, hipDeviceAttributeMultiprocessorCount, dev) != hipSuccess) { grid = -1; return; }
        if (hipFuncSetAttribute((const void*)fwd, hipFuncAttributeMaxDynamicSharedMemorySize, LDS_BYTES) != hipSuccess) { fprintf(stderr, "kernel_launch: hipFuncSetAttribute failed\n"); grid = -1; return; }
        if (hipOccupancyMaxActiveBlocksPerMultiprocessor(&per_cu, (const void*)fwd, 512, LDS_BYTES) != hipSuccess || per_cu < 1) { fprintf(stderr, "kernel_launch: occupancy query reports %d\n", per_cu); }
        (void)hipGetLastError();
        grid = cus;
    }
    if (grid < 0) return;
    (void)hipMemsetAsync((char*)d_ws + WS_CTL, 0, CTL_ZERO_BYTES, stream);
    Args a{};
    for (int i = 0; i < 19; ++i) a.in[i] = (const float*)d_in[i];
    a.out = (float*)d_out; a.ws = (unsigned char*)d_ws;
#if MK_N_LAUNCHES == 1
    a.ph_lo = 0; a.ph_hi = NPHASE;
    hipLaunchKernelGGL(fwd, dim3(grid), dim3(512), LDS_BYTES, stream, a);
#else
    for (int li = 0; li < NPHASE; ++li) { a.ph_lo = li; a.ph_hi = li + 1; hipLaunchKernelGGL(fwd, dim3(grid), dim3(512), LDS_BYTES, stream, a); }
#endif
}
```

```cpp
#include <hip/hip_runtime.h>
#include <cstdio>
#include <cstdint>

#ifndef MK_N_LAUNCHES
#define MK_N_LAUNCHES 1
#endif

#ifndef MOE_FP8
#define MOE_FP8 1
#endif
#define LAS __attribute__((address_space(3)))
#define GAS __attribute__((address_space(1)))
typedef unsigned short bf16_t;
typedef short bf16x8 __attribute__((ext_vector_type(8)));
typedef short s16x4 __attribute__((ext_vector_type(4)));
typedef short v4i16_t __attribute__((ext_vector_type(4)));
typedef float f32x2 __attribute__((ext_vector_type(2)));
typedef float f32x4 __attribute__((ext_vector_type(4)));
typedef float f32x16 __attribute__((ext_vector_type(16)));
typedef unsigned u32x2 __attribute__((ext_vector_type(2)));
typedef unsigned u32x4 __attribute__((ext_vector_type(4)));
typedef __bf16 bf16x2_t __attribute__((ext_vector_type(2)));
typedef int v8i32 __attribute__((ext_vector_type(8)));
typedef unsigned u32x8 __attribute__((ext_vector_type(8)));

constexpr int D = 1024, NB = 4, SEQ = 4096, T = NB * SEQ;
constexpr int DIN = 3584;
constexpr int C_QA = 0, C_KA = 512, C_VA = 1024, C_QR = 1536, C_FR = 2048, C_IR = 2560, C_GR = 3072;
constexpr int NE = 32;
constexpr float EPS = 1e-6f;
constexpr int NPHASE = 11;
constexpr int LIST_CAP = 16384;
constexpr int ACT_ROWS = T * 4 + NE * 256;

constexpr size_t MiB = 1u << 20;
constexpr size_t WS_CTL = 0, CTL_ZERO_BYTES = 1 * MiB;
constexpr size_t WS_MOD = 1 * MiB;
constexpr size_t WS_WIN = 2 * MiB;
constexpr size_t WS_WOUT = 10 * MiB;
constexpr size_t WS_WRT = 12 * MiB;
constexpr size_t WS_WGU = 16 * MiB;
constexpr size_t WS_WDN = 144 * MiB;
constexpr size_t WS_H = 208 * MiB;
constexpr size_t WS_PROJ = 240 * MiB;
constexpr size_t WS_YCAT = 352 * MiB;
constexpr size_t WS_H8 = 320 * MiB;
constexpr size_t WS_HLO = 240 * MiB;
constexpr size_t WS_ACT = 240 * MiB;
constexpr size_t WS_PARTO = 384 * MiB;
constexpr size_t WS_LSE = 432 * MiB;
constexpr size_t WS_OLOC = 434 * MiB;
constexpr size_t WS_QE = 450 * MiB;
constexpr size_t WS_SLOC = 466 * MiB;
constexpr size_t WS_DTOT = 482 * MiB;
constexpr size_t WS_SIN = 483 * MiB;
constexpr size_t WS_Y = 492 * MiB;
constexpr size_t WS_YPAIR = 384 * MiB;
constexpr size_t WS_X2 = 556 * MiB;
constexpr size_t WS_TOK = 620 * MiB;
constexpr size_t WS_END = 624 * MiB;
static_assert(WS_ACT + (size_t)ACT_ROWS * 2048 <= WS_PARTO, "act overlay");
static_assert(WS_YPAIR + (size_t)T * 4 * 2048 <= WS_X2, "ypair overlay");

constexpr int CW_TMO = 0;
constexpr int CW_BAR = 4096;
constexpr int CW_CNT = 8192;

constexpr int RING_BYTES = 131072;
constexpr int MISC_OFF = RING_BYTES;
constexpr int IDXBUF_OFF = RING_BYTES + 8192;
constexpr int BARW_OFF = RING_BYTES + 16384 - 16;
constexpr int LDS_BYTES = RING_BYTES + 16384;

constexpr float F8_SA = 32.f, F8_SACT = 4.f, F8_SW = 1024.f;
__device__ __forceinline__ unsigned pk4_fp8(float a, float b, float c, float d) {
    a = __builtin_amdgcn_fmed3f(a, -448.f, 448.f); b = __builtin_amdgcn_fmed3f(b, -448.f, 448.f); c = __builtin_amdgcn_fmed3f(c, -448.f, 448.f); d = __builtin_amdgcn_fmed3f(d, -448.f, 448.f);
    int v = 0; v = __builtin_amdgcn_cvt_pk_fp8_f32(a, b, v, false); v = __builtin_amdgcn_cvt_pk_fp8_f32(c, d, v, true); return (unsigned)v;
}
__device__ __forceinline__ float bf2f(unsigned v) { return __uint_as_float(v << 16); }
__device__ __forceinline__ float bflo(unsigned v) { return __uint_as_float(v << 16); }
__device__ __forceinline__ float bfhi(unsigned v) { return __uint_as_float(v & 0xffff0000u); }
__device__ __forceinline__ unsigned pk2(float lo, float hi) { f32x2 v = {lo, hi}; bf16x2_t b = __builtin_convertvector(v, bf16x2_t); return __builtin_bit_cast(unsigned, b); }
__device__ __forceinline__ float wave_sum(float v) {
#pragma unroll
    for (int o = 32; o >= 1; o >>= 1) v += __shfl_xor(v, o);
    return v;
}
__device__ __forceinline__ float rcpf_(float x) { return __builtin_amdgcn_rcpf(x); }
__device__ __forceinline__ float sigmoidf_(float x) { return __builtin_amdgcn_rcpf(1.f + __builtin_amdgcn_exp2f(-1.4426950408889634f * x)); }
__device__ __forceinline__ int crow(int r, int hi) { return (r & 3) + 8 * (r >> 2) + 4 * hi; }
__device__ __forceinline__ s16x4 tr_read(const LAS unsigned char* p) { return __builtin_bit_cast(s16x4, __builtin_amdgcn_ds_read_tr16_b64_v4i16((LAS v4i16_t*)p)); }
__device__ __forceinline__ bf16x8 cat8(s16x4 lo, s16x4 hi) { return (bf16x8){lo[0], lo[1], lo[2], lo[3], hi[0], hi[1], hi[2], hi[3]}; }
__device__ __forceinline__ bf16x8 pack_step(const f32x16& x, int s) {
    u32x4 p; p.x = pk2(x[8 * s], x[8 * s + 1]); p.y = pk2(x[8 * s + 2], x[8 * s + 3]); p.z = pk2(x[8 * s + 4], x[8 * s + 5]); p.w = pk2(x[8 * s + 6], x[8 * s + 7]);
    return __builtin_bit_cast(bf16x8, p);
}
#define MFMA32(a, b, c) __builtin_amdgcn_mfma_f32_32x32x16_bf16((a), (b), (c), 0, 0, 0)

#define XB_TMO      128
#define XB_XCNT(j)  (256  + 64 * (j))
#define XB_XSUB(j)  (1280 + 64 * (j))
#define XB_XGEN(j)  (2304 + 64 * (j))
#define XB_TOP      3328
#define XB_TOPGEN   3392
#define XCD_BAR_WORDS 3456
#define XB_SPIN_CAP (1u << 18)
__device__ __forceinline__ unsigned xb_ld(unsigned* p)              { return __hip_atomic_load(p, __ATOMIC_RELAXED, __HIP_MEMORY_SCOPE_AGENT); }
__device__ __forceinline__ unsigned xb_add(unsigned* p, unsigned v) { return __hip_atomic_fetch_add(p, v, __ATOMIC_RELAXED, __HIP_MEMORY_SCOPE_AGENT); }
__device__ __forceinline__ unsigned xb_xcc_id() { return (unsigned)__builtin_amdgcn_s_getreg((3 << 11) | 20) & 0xFu; }
#define XB_SPIN(cond, bar) do { unsigned _sp = 0; while (cond) { __builtin_amdgcn_s_sleep(1); \
    if ((++_sp & 255u) == 0u) { if (xb_ld(&(bar)[XB_TMO])) break; if (_sp > XB_SPIN_CAP) { atomicAdd(&(bar)[XB_TMO], 1u); break; } } } } while (0)
struct XcdBarrier { unsigned* bar; unsigned x; volatile LAS unsigned* st; };
__device__ __forceinline__ XcdBarrier xcd_barrier_post(unsigned* bar, volatile LAS unsigned* st) {
    XcdBarrier b; b.bar = bar; b.x = xb_xcc_id(); b.st = st;
    if (threadIdx.x == 0) (void)xb_add(&bar[XB_XCNT(b.x)], 1u);
    return b;
}
__device__ __forceinline__ void xcd_barrier_complete(unsigned* bar, unsigned x, unsigned& nloc, unsigned& nx) {
    const unsigned G = gridDim.x * gridDim.y * gridDim.z;
    unsigned sum, cnt, mine, sp = 0u;
    for (;;) {
        sum = 0u; cnt = 0u; mine = 0u;
#pragma unroll
        for (unsigned j = 0; j < 16; ++j) { const unsigned c = xb_ld(&bar[XB_XCNT(j)]); sum += c; cnt += (c > 0u) ? 1u : 0u; mine = (j == x) ? c : mine; }
        if (sum == G) break;
        __builtin_amdgcn_s_sleep(1);
        if ((++sp & 255u) == 0u) { if (xb_ld(&bar[XB_TMO])) break; if (sp > XB_SPIN_CAP) { atomicAdd(&bar[XB_TMO], 1u); break; } }
    }
    nloc = mine > 0u ? mine : 1u; nx = cnt > 0u ? cnt : 1u;
}
__device__ __forceinline__ void xcd_barrier(const XcdBarrier& b) {
    asm volatile("s_waitcnt vmcnt(0)" ::: "memory");
    __syncthreads();
    if (threadIdx.x == 0) {
        unsigned* bar = b.bar;
        __builtin_amdgcn_s_waitcnt(0);
        unsigned nloc = b.st[0], nx = b.st[1];
        if (nloc == 0u) { xcd_barrier_complete(bar, b.x, nloc, nx); b.st[0] = nloc; b.st[1] = nx; }
        const unsigned old = xb_add(&bar[XB_XSUB(b.x)], 1u);
        const unsigned gen = old / nloc;
        if (old + 1u == (gen + 1u) * nloc) {
            __builtin_amdgcn_fence(__ATOMIC_RELEASE, "agent");
            asm volatile("s_waitcnt vmcnt(0)" ::: "memory");
            const unsigned og = xb_add(&bar[XB_TOP], 1u);
            const unsigned tg = og / nx;
            if (og + 1u == (tg + 1u) * nx) xb_add(&bar[XB_TOPGEN], 1u);
            else XB_SPIN(xb_ld(&bar[XB_TOPGEN]) == tg, bar);
            __builtin_amdgcn_fence(__ATOMIC_ACQUIRE, "agent");
            xb_add(&bar[XB_XGEN(b.x)], 1u);
            asm volatile("s_waitcnt vmcnt(0)" ::: "memory");
        } else {
            XB_SPIN(xb_ld(&bar[XB_XGEN(b.x)]) == gen, bar);
            __builtin_amdgcn_fence(__ATOMIC_ACQUIRE, "agent");
            asm volatile("s_waitcnt vmcnt(0)" ::: "memory");
        }
    }
    __syncthreads();
}

namespace pg8 {
constexpr int BM = 256, BK = 64, HALF = 128, HTB = HALF * BK * 2, NXCD = 8, WGM = 8, KD = 1024;
__host__ __device__ __forceinline__ int lds_byte(int r, int c) { const int st = (r >> 4) * 2 + (c >> 5), rr = r & 15, cc = c & 31, ob = rr * 64 + cc * 2; return st * 1024 + (ob ^ (((ob >> 9) & 1) << 5)); }
__host__ __device__ __forceinline__ void stage_rc(int b, int& R, int& C) { const int st = b / 1024, sb = b % 1024, swz = sb ^ (((sb >> 9) & 1) << 5); R = (st >> 1) * 16 + swz / 64; C = (st & 1) * 32 + (swz % 64) / 2; }
__host__ __device__ __forceinline__ int perm32(int rho) { const int n = rho >> 4, i = rho & 15; return 8 * (i >> 2) + 4 * n + (i & 3); }

struct Unit { int pm, pn, e, rt, nvalid; };

struct StaticOrder {
    int nM, nN, nwg, G, c;
    __device__ void init(int M, int N, int G_, int c_) { nM = M / BM; nN = N / BM; nwg = nM * nN; G = G_; c = c_; }
    __device__ bool next(int i, Unit& u) const {
        const long L = (long)i * G + c; if (L >= nwg) return false;
        int wgid = (int)L; { const int q = nwg / NXCD, r = nwg % NXCD, xcd = wgid % NXCD, off = wgid / NXCD; wgid = (xcd < r ? xcd * (q + 1) : r * (q + 1) + (xcd - r) * q) + off; }
        const int nig = WGM * nN, gid = wgid / nig, fm = gid * WGM, gsz = (nM - fm) < WGM ? (nM - fm) : WGM;
        u.pm = fm + ((wgid % nig) % gsz); u.pn = (wgid % nig) / gsz; u.e = 0; u.rt = 0; u.nvalid = 256; return true;
    }
};
struct MoeOrder {
    const LAS int* cnt; const LAS int* tbase; const LAS int* sorted_e; int ncol, G, c;
    __device__ bool next(int i, Unit& u) const {
        const int ng = (G % 8 == 0) ? 8 : 1, nl = G / ng, x = c % ng, j = c / ng;
        int pos = i * nl + j; int e = -1;
        if (ng == 8) {
#pragma unroll
            for (int q = 0; q < 4; ++q) { const int rk = (q == 0) ? x : (q == 1) ? 15 - x : (q == 2) ? 16 + x : 31 - x; const int eq = sorted_e[rk]; const int n = ((cnt[eq] + 255) >> 8) * ncol;
                if (e < 0) { if (pos < n) e = eq; else pos -= n; } }
        } else {
            for (int q = 0; q < NE; ++q) { const int n = ((cnt[q] + 255) >> 8) * ncol; if (e < 0) { if (pos < n) e = q; else pos -= n; } }
        }
        if (e < 0) return false;
        u.e = __builtin_amdgcn_readfirstlane(e); u.rt = __builtin_amdgcn_readfirstlane(pos / ncol); u.pn = __builtin_amdgcn_readfirstlane(pos % ncol);
        u.pm = __builtin_amdgcn_readfirstlane(tbase[e] + pos / ncol); const int left = cnt[e] - u.rt * 256; u.nvalid = __builtin_amdgcn_readfirstlane(left < 256 ? left : 256); return true;
    }
};
struct ProbPlain {
    static constexpr bool GATHER = false; static constexpr int ELT = 2;
    const bf16_t* A; const bf16_t* Bt;
    __device__ __forceinline__ const char* a_ptr(const Unit& u) const { return (const char*)A + (size_t)u.pm * (256 * KD * 2); }
    __device__ __forceinline__ const char* b_ptr(const Unit& u) const { return (const char*)Bt + (size_t)u.pn * (256 * KD * 2); }
    __device__ __forceinline__ const int* list_ptr(const Unit&) const { return nullptr; }
};
template <int ELT_> struct ProbGU {
    static constexpr bool GATHER = true; static constexpr int ELT = ELT_;
    const void* A; const void* Bt; const int* list;
    __device__ __forceinline__ const char* a_ptr(const Unit&) const { return (const char*)A; }
    __device__ __forceinline__ const char* b_ptr(const Unit& u) const { return (const char*)Bt + ((size_t)u.e * 2048 + (size_t)u.pn * 256) * (KD * ELT); }
    __device__ __forceinline__ const int* list_ptr(const Unit& u) const { return list + 2 * ((size_t)u.e * LIST_CAP + u.rt * 256); }
};
template <int ELT_> struct ProbDown {
    static constexpr bool GATHER = false; static constexpr int ELT = ELT_;
    const void* A; const void* Bt;
    __device__ __forceinline__ const char* a_ptr(const Unit& u) const { return (const char*)A + (size_t)u.pm * (256 * KD * ELT); }
    __device__ __forceinline__ const char* b_ptr(const Unit& u) const { return (const char*)Bt + ((size_t)u.e * 1024 + (size_t)u.pn * 256) * (KD * ELT); }
    __device__ __forceinline__ const int* list_ptr(const Unit&) const { return nullptr; }
};

struct EpiBf16 {
    static constexpr bool PERM = true;
    bf16_t* O; int ldc;
    __device__ __forceinline__ void operator()(const f32x4 (&acc)[2][2][4][2], const Unit& u, int wr, int wc, int fr, int fq) const {
        const int row0 = u.pm * BM + wr * 64 + fr, col0 = u.pn * BM + wc * 32 + 8 * fq;
#pragma unroll
        for (int ai = 0; ai < 2; ++ai)
#pragma unroll
            for (int m = 0; m < 4; ++m) { bf16_t* rowp = O + (size_t)(row0 + ai * HALF + m * 16) * ldc + col0;
#pragma unroll
                for (int bj = 0; bj < 2; ++bj) { const f32x4 v0 = acc[ai][bj][m][0], v1 = acc[ai][bj][m][1];
                    u32x4 w; w.x = pk2(v0[0], v0[1]); w.y = pk2(v0[2], v0[3]); w.z = pk2(v1[0], v1[1]); w.w = pk2(v1[2], v1[3]);
                    *(u32x4*)(rowp + bj * HALF) = w; } }
    }
};
struct EpiF32 {
    static constexpr bool PERM = false;
    float* C; int ldc;
    __device__ __forceinline__ void operator()(const f32x4 (&acc)[2][2][4][2], const Unit& u, int wr, int wc, int fr, int fq) const {
        const int row0 = u.pm * BM + wr * 64 + fr, col0 = u.pn * BM + wc * 32 + 4 * fq;
#pragma unroll
        for (int ai = 0; ai < 2; ++ai)
#pragma unroll
            for (int m = 0; m < 4; ++m) { float* rowp = C + (size_t)(row0 + ai * HALF + m * 16) * ldc + col0;
#pragma unroll
                for (int bj = 0; bj < 2; ++bj)
#pragma unroll
                    for (int n = 0; n < 2; ++n) *(f32x4*)(rowp + bj * HALF + n * 16) = acc[ai][bj][m][n]; }
    }
};
template <bool F8> struct EpiGU {
    static constexpr bool PERM = true;
    void* act; const float* b_gu;
    __device__ __forceinline__ void operator()(const f32x4 (&acc)[2][2][4][2], const Unit& u, int wr, int wc, int fr, int fq) const {
        const int row0 = u.pm * BM + wr * 64 + fr, col0 = u.pn * 128 + wc * 32 + 8 * fq;
        const float* bg = b_gu + (size_t)u.e * 2048 + col0;
        const f32x4 bg0 = *(const f32x4*)(bg), bg1 = *(const f32x4*)(bg + 4), bl0 = *(const f32x4*)(bg + 1024), bl1 = *(const f32x4*)(bg + 1028);
        __builtin_amdgcn_s_waitcnt(0x0F70);
        const float sc = F8 ? 1.f / (F8_SA * F8_SW) : 1.f;
#pragma unroll
        for (int ai = 0; ai < 2; ++ai)
#pragma unroll
            for (int m = 0; m < 4; ++m) {
                float r[8];
#pragma unroll
                for (int n = 0; n < 2; ++n)
#pragma unroll
                    for (int j = 0; j < 4; ++j) {
                        float g = acc[ai][0][m][n][j] * sc + (n ? bg1[j] : bg0[j]); float l = acc[ai][1][m][n][j] * sc + (n ? bl1[j] : bl0[j]);
                        g = fminf(g, 7.0f); l = __builtin_amdgcn_fmed3f(l, -7.0f, 7.0f);
                        r[n * 4 + j] = g * __builtin_amdgcn_rcpf(1.f + __builtin_amdgcn_exp2f(-1.702f * 1.4426950408889634f * g)) * (l + 1.0f); }
                if (F8) { u32x2 w; w.x = pk4_fp8(r[0] * F8_SACT, r[1] * F8_SACT, r[2] * F8_SACT, r[3] * F8_SACT); w.y = pk4_fp8(r[4] * F8_SACT, r[5] * F8_SACT, r[6] * F8_SACT, r[7] * F8_SACT);
                    *(u32x2*)((unsigned char*)act + (size_t)(row0 + ai * HALF + m * 16) * 1024 + col0) = w; }
                else { u32x4 w; w.x = pk2(r[0], r[1]); w.y = pk2(r[2], r[3]); w.z = pk2(r[4], r[5]); w.w = pk2(r[6], r[7]);
                    *(u32x4*)((bf16_t*)act + (size_t)(row0 + ai * HALF + m * 16) * 1024 + col0) = w; } }
    }
};
template <bool F8> struct EpiDown {
    static constexpr bool PERM = true;
    bf16_t* ypair; const float* b_down; const int* list;
    __device__ __forceinline__ void operator()(const f32x4 (&acc)[2][2][4][2], const Unit& u, int wr, int wc, int fr, int fq) const {
        const int col0 = u.pn * BM + wc * 32 + 8 * fq;
        const float* bd = b_down + (size_t)u.e * 1024 + col0;
        f32x4 bv[2][2];
#pragma unroll
        for (int bj = 0; bj < 2; ++bj)
#pragma unroll
            for (int n = 0; n < 2; ++n) bv[bj][n] = *(const f32x4*)(bd + bj * HALF + 4 * n);
        const u32x2* lp = (const u32x2*)list + (size_t)u.e * LIST_CAP + u.rt * 256;
        int pr[2][4]; float gt[2][4];
#pragma unroll
        for (int ai = 0; ai < 2; ++ai)
#pragma unroll
            for (int m = 0; m < 4; ++m) { const int r = ai * HALF + wr * 64 + m * 16 + fr; const bool ok = r < u.nvalid; const u32x2 en = lp[ok ? r : 0]; pr[ai][m] = ok ? (int)en.x : -1; gt[ai][m] = __uint_as_float(en.y); }
        __builtin_amdgcn_s_waitcnt(0x0F70);
#pragma unroll
        for (int ai = 0; ai < 2; ++ai)
#pragma unroll
            for (int m = 0; m < 4; ++m) {
                if (pr[ai][m] >= 0) {
                    bf16_t* rowp = ypair + (size_t)pr[ai][m] * 1024 + col0; const float g = gt[ai][m]; const float sc = F8 ? 1.f / (F8_SACT * F8_SW) : 1.f;
#pragma unroll
                    for (int bj = 0; bj < 2; ++bj) { const f32x4 v0 = (acc[ai][bj][m][0] * sc + bv[bj][0]) * g, v1 = (acc[ai][bj][m][1] * sc + bv[bj][1]) * g;
                        u32x4 w; w.x = pk2(v0[0], v0[1]); w.y = pk2(v0[2], v0[3]); w.z = pk2(v1[0], v1[1]); w.w = pk2(v1[2], v1[3]);
                        *(u32x4*)(rowp + bj * HALF) = w; }
                }
            }
    }
};

template <class Epi, class Sched, class Prob>
__device__ __forceinline__ void gemm_phase(LAS unsigned char* lds, const Prob& P, const Sched& S, const Epi& E) {
    const int tid = threadIdx.x, wid = __builtin_amdgcn_readfirstlane(tid >> 6), lane = tid & 63, wr = wid >> 2, wc = wid & 3, fr = lane & 15, fq = lane >> 4;
    constexpr int ELT = Prob::ELT, K = KD * ELT / 2  , nt = (KD * ELT) / (BK * 2);
    unsigned voffA, voffB;
#define PG8_MKOFF(T) do { int R, C; stage_rc((T) * 16, R, C); const int Rb = Epi::PERM ? ((R & ~31) + perm32(R & 31)) : R; voffA = (unsigned)(R * K + C) * 2u; voffB = (unsigned)(Rb * K + C) * 2u; } while (0)
    PG8_MKOFF(tid);
    constexpr unsigned istep = 64u * (unsigned)K * 2u;
    unsigned voffG[2][2] = {{0u, 0u}, {0u, 0u}};
    LAS int* idxbuf = (LAS int*)(lds + IDXBUF_OFF);
    const size_t kstep = (size_t)(BK * 2);
    const size_t hstep = (size_t)HALF * K * 2;
    const unsigned ldsw = (unsigned)wid * 1024u;
    const int aoff = lds_byte(wr * 64 + fr, fq * 8 * (3 - ELT)), boff = lds_byte(wc * 32 + fr, fq * 8 * (3 - ELT));
#define PG8_SA(b, h) (((b) * 2 + (h)) * HTB)
#define PG8_SB(b, h) ((4 + (b) * 2 + (h)) * HTB)
#define PG8_STAGE(bufoff, gbase, voff) do { _Pragma("unroll") for (int _i = 0; _i < 2; ++_i) \
        __builtin_amdgcn_global_load_lds((const unsigned*)((const char*)(gbase) + _i * istep + (voff)), (LAS unsigned*)(lds + (bufoff) + ldsw + _i * 8192), 16, 0, 0); } while (0)
#define PG8_GSTAGE(bufoff, gbase, voff) do { _Pragma("unroll") for (int _i = 0; _i < 2; ++_i) \
        __builtin_amdgcn_global_load_lds((const unsigned*)((const char*)(gbase) + (voff)[_i]), (LAS unsigned*)(lds + (bufoff) + ldsw + _i * 8192), 16, 0, 0); } while (0)
#define PG8_ASTAGE(bufoff, gbase, h) do { if constexpr (Prob::GATHER) { PG8_GSTAGE(bufoff, gbase, voffG[h]); } else { PG8_STAGE(bufoff, (gbase) + (h) * hstep, voffA); } } while (0)
#define PG8_LD8(addr) __builtin_shufflevector(*(const LAS u32x4*)(addr), *(const LAS u32x4*)((addr) + 16), 0, 1, 2, 3, 4, 5, 6, 7)
#define PG8_LDA(dst, b, h) do { if constexpr (ELT == 2) { _Pragma("unroll") for (int m = 0; m < 4; ++m) _Pragma("unroll") for (int k = 0; k < 2; ++k) dst[m][k] = *(const LAS u32x4*)(lds + PG8_SA(b, h) + aoff + m * 2048 + k * 1024); } \
        else { _Pragma("unroll") for (int m = 0; m < 4; ++m) dst##8[m] = PG8_LD8(lds + PG8_SA(b, h) + aoff + m * 2048); } } while (0)
#define PG8_LDB(dst, b, h) do { if constexpr (ELT == 2) { _Pragma("unroll") for (int n = 0; n < 2; ++n) _Pragma("unroll") for (int k = 0; k < 2; ++k) dst[n][k] = *(const LAS u32x4*)(lds + PG8_SB(b, h) + boff + n * 2048 + k * 1024); } \
        else { _Pragma("unroll") for (int n = 0; n < 2; ++n) dst##8[n] = PG8_LD8(lds + PG8_SB(b, h) + boff + n * 2048); } } while (0)
#define PG8_MMA(ai, bj, At, Bt) do { __builtin_amdgcn_s_setprio(1); if constexpr (ELT == 2) { _Pragma("unroll") for (int m = 0; m < 4; ++m) _Pragma("unroll") for (int n = 0; n < 2; ++n) _Pragma("unroll") for (int k = 0; k < 2; ++k) \
        acc[ai][bj][m][n] = __builtin_amdgcn_mfma_f32_16x16x32_bf16(__builtin_bit_cast(bf16x8, Bt[n][k]), __builtin_bit_cast(bf16x8, At[m][k]), acc[ai][bj][m][n], 0, 0, 0); } \
        else { _Pragma("unroll") for (int m = 0; m < 4; ++m) _Pragma("unroll") for (int n = 0; n < 2; ++n) \
        acc[ai][bj][m][n] = __builtin_amdgcn_mfma_scale_f32_16x16x128_f8f6f4(__builtin_bit_cast(v8i32, Bt##8[n]), __builtin_bit_cast(v8i32, At##8[m]), acc[ai][bj][m][n], 0, 0, 0, 0x7F7F7F7F, 0, 0x7F7F7F7F); } \
        __builtin_amdgcn_s_setprio(0); } while (0)
#define PG8_WAIT_V(n) asm volatile("s_waitcnt vmcnt(" #n ")" ::: "memory")
#define PG8_WAIT_L(n) asm volatile("s_waitcnt lgkmcnt(" #n ")" ::: "memory")
#define PG8_BAR __builtin_amdgcn_s_barrier()
#define PG8_SCHED __builtin_amdgcn_sched_barrier(0)
    Unit cur, nxt; int ui = 0;
    if (!S.next(0, cur)) return;
    f32x4 acc[2][2][4][2];
#pragma unroll
    for (int a = 0; a < 2; ++a)
#pragma unroll
        for (int b = 0; b < 2; ++b)
#pragma unroll
            for (int m = 0; m < 4; ++m)
#pragma unroll
                for (int n = 0; n < 2; ++n) acc[a][b][m][n] = (f32x4){0.f, 0.f, 0.f, 0.f};
    u32x4 At[4][2], B0[2][2], B1[2][2];
    u32x8 At8[4], B08[2], B18[2];
    const char* cA = P.a_ptr(cur); const char* cB = P.b_ptr(cur);
    if constexpr (Prob::GATHER) {
        const int* lp = P.list_ptr(cur); const int R0 = (wid >> 1) * 16 + (lane >> 2); const unsigned coff = (unsigned)((wid & 1) * 32 + (((lane & 3) * 8) ^ ((lane >> 5) << 4))) * 2u;
#pragma unroll
        for (int h = 0; h < 2; ++h)
#pragma unroll
            for (int i = 0; i < 2; ++i) { const int row = h * 128 + R0 + 64 * i; const int pair = (row < cur.nvalid) ? lp[2 * row] : 0; voffG[h][i] = (unsigned)(pair >> 2) * (unsigned)(KD * ELT) + coff; }
        Unit u1; if (S.next(1, u1) && tid < 256) idxbuf[256 + tid] = P.list_ptr(u1)[2 * tid];
    }
    PG8_STAGE(PG8_SB(0, 0), cB, voffB); PG8_STAGE(PG8_SB(0, 1), cB + hstep, voffB); PG8_ASTAGE(PG8_SA(0, 0), cA, 0); PG8_ASTAGE(PG8_SA(0, 1), cA, 1);
    if (wr == 1) PG8_BAR;
    PG8_WAIT_V(2); PG8_BAR;
    PG8_STAGE(PG8_SB(1, 0), cB + kstep, voffB); PG8_ASTAGE(PG8_SA(1, 0), cA + kstep, 0); PG8_STAGE(PG8_SB(1, 1), cB + hstep + kstep, voffB);
    PG8_WAIT_V(6); PG8_BAR;
    for (;;) {
        const bool has_next = S.next(ui + 1, nxt);
        const char* nA = has_next ? P.a_ptr(nxt) : cA; const char* nB = has_next ? P.b_ptr(nxt) : cB;
#pragma unroll 1
        for (int t = 0; t < nt; t += 2) {
            const bool last = (t == nt - 2);
            const char* a1 = cA + (size_t)(t + 1) * kstep;
            const char* a2 = last ? nA : cA + (size_t)(t + 2) * kstep; const char* b2 = last ? nB : cB + (size_t)(t + 2) * kstep;
            const char* a3 = a2 + kstep; const char* b3 = b2 + kstep;
            { int tz = threadIdx.x; asm volatile("" : "+v"(tz)); PG8_MKOFF(tz); }
            PG8_LDB(B0, 0, 0); PG8_LDB(B1, 0, 1); PG8_SCHED; PG8_LDA(At, 0, 0); PG8_ASTAGE(PG8_SA(1, 1), a1, 1);
            if constexpr (Prob::GATHER) { if (last && has_next) {
                const int R0 = (wid >> 1) * 16 + (lane >> 2); const unsigned coff = (unsigned)((wid & 1) * 32 + (((lane & 3) * 8) ^ ((lane >> 5) << 4))) * 2u; const LAS int* ib = idxbuf + ((ui + 1) & 1) * 256;
#pragma unroll
                for (int h = 0; h < 2; ++h)
#pragma unroll
                    for (int i = 0; i < 2; ++i) { const int row = h * 128 + R0 + 64 * i; const int pair = (row < nxt.nvalid) ? ib[row] : 0; voffG[h][i] = (unsigned)(pair >> 2) * (unsigned)(KD * ELT) + coff; } } }
            PG8_WAIT_V(8); PG8_WAIT_L(0); PG8_BAR; PG8_MMA(0, 0, At, B0); PG8_MMA(0, 1, At, B1); PG8_BAR; PG8_SCHED;
            PG8_LDA(At, 0, 1); PG8_STAGE(PG8_SB(0, 0), b2, voffB); PG8_STAGE(PG8_SB(0, 1), b2 + hstep, voffB); PG8_ASTAGE(PG8_SA(0, 0), a2, 0);
            PG8_WAIT_V(8); PG8_WAIT_L(0); PG8_BAR; PG8_MMA(1, 0, At, B0); PG8_MMA(1, 1, At, B1); PG8_BAR; PG8_SCHED;
            PG8_LDB(B0, 1, 0); PG8_LDB(B1, 1, 1); PG8_SCHED; PG8_LDA(At, 1, 0); PG8_ASTAGE(PG8_SA(0, 1), a2, 1);
            PG8_WAIT_V(8); PG8_WAIT_L(0); PG8_BAR; PG8_MMA(0, 0, At, B0); PG8_MMA(0, 1, At, B1); PG8_BAR; PG8_SCHED;
            PG8_LDA(At, 1, 1); PG8_STAGE(PG8_SB(1, 0), b3, voffB); PG8_STAGE(PG8_SB(1, 1), b3 + hstep, voffB); PG8_ASTAGE(PG8_SA(1, 0), a3, 0);
            PG8_WAIT_V(8); PG8_WAIT_L(0); PG8_BAR; PG8_MMA(1, 0, At, B0); PG8_MMA(1, 1, At, B1); PG8_BAR; PG8_SCHED;
        }
        if (wr == 0) PG8_BAR;
        int nidx = 0; bool have2 = false;
        if constexpr (Prob::GATHER) { Unit u2; have2 = S.next(ui + 2, u2); if (have2 && tid < 256) nidx = P.list_ptr(u2)[2 * tid]; }
        { int tz = threadIdx.x; asm volatile("" : "+v"(tz));
          const int wz = tz >> 6, lz = tz & 63; E(acc, cur, wz >> 2, wz & 3, lz & 15, lz >> 4); }
        if constexpr (Prob::GATHER) { if (have2 && tid < 256) idxbuf[(ui & 1) * 256 + tid] = nidx; }
        if (!has_next) break;
#pragma unroll
        for (int a = 0; a < 2; ++a)
#pragma unroll
            for (int b = 0; b < 2; ++b)
#pragma unroll
                for (int m = 0; m < 4; ++m)
#pragma unroll
                    for (int n = 0; n < 2; ++n) acc[a][b][m][n] = (f32x4){0.f, 0.f, 0.f, 0.f};
        cur = nxt; cA = nA; cB = nB; ++ui;
        if (wr == 1) PG8_BAR;
    }
    PG8_WAIT_V(0);
    PG8_BAR;
#undef PG8_SA
#undef PG8_SB
#undef PG8_STAGE
#undef PG8_GSTAGE
#undef PG8_MKOFF
#undef PG8_ASTAGE
#undef PG8_LDA
#undef PG8_LDB
#undef PG8_MMA
#undef PG8_WAIT_V
#undef PG8_WAIT_L
#undef PG8_BAR
#undef PG8_SCHED
}
}

struct Ctx {
    LAS unsigned char* lds; int tid, lane, wave, G, bid;
    const float *x, *c, *w_ada, *b_ada, *g_pre_mix, *g_post_mix, *w_in, *attn_norm_w, *hgrn_lb, *hgrn_norm_w, *w_out, *g_pre_ffn, *g_post_ffn, *w_router, *b_router, *w_gu, *b_gu, *w_down, *b_down;
    float* out; unsigned char* ws;
};
#define LDS_FENCE() asm volatile("s_waitcnt lgkmcnt(0)" ::: "memory")

__device__ __forceinline__ void p0_transpose_item(const float* W, int N, int k0, int n0, bf16_t* dst_row0, LAS float* scr, int lane) {
    const int q = lane & 7, kr = lane >> 3;
    f32x4 v[8];
#pragma unroll
    for (int i = 0; i < 8; ++i) v[i] = *(const f32x4*)(W + (size_t)(k0 + 8 * i + kr) * N + n0 + 4 * q);
#pragma unroll
    for (int i = 0; i < 8; ++i) { const int k = 8 * i + kr;
        scr[(4 * q + 0) * 65 + k] = v[i].x; scr[(4 * q + 1) * 65 + k] = v[i].y; scr[(4 * q + 2) * 65 + k] = v[i].z; scr[(4 * q + 3) * 65 + k] = v[i].w; }
    LDS_FENCE();
    const int c = lane & 7;
#pragma unroll
    for (int j = 0; j < 4; ++j) { const int n = (lane >> 3) + 8 * j; const LAS float* s = scr + n * 65 + 8 * c;
        u32x4 o; o.x = pk2(s[0], s[1]); o.y = pk2(s[2], s[3]); o.z = pk2(s[4], s[5]); o.w = pk2(s[6], s[7]);
        *(u32x4*)(dst_row0 + (size_t)n * 1024 + k0 + 8 * c) = o; }
    LDS_FENCE();
}
__device__ __forceinline__ void p0_transpose_item8(const float* W, int N, int k0, int n0, unsigned char* dst_row0, LAS float* scr, int lane) {
    const int q = lane & 7, kr = lane >> 3;
    f32x4 v[8];
#pragma unroll
    for (int i = 0; i < 8; ++i) v[i] = *(const f32x4*)(W + (size_t)(k0 + 8 * i + kr) * N + n0 + 4 * q);
#pragma unroll
    for (int i = 0; i < 8; ++i) { const int k = 8 * i + kr;
        scr[(4 * q + 0) * 65 + k] = v[i].x; scr[(4 * q + 1) * 65 + k] = v[i].y; scr[(4 * q + 2) * 65 + k] = v[i].z; scr[(4 * q + 3) * 65 + k] = v[i].w; }
    LDS_FENCE();
    const int c = lane & 3;
#pragma unroll
    for (int j = 0; j < 2; ++j) { const int n = (lane >> 2) + 16 * j; const LAS float* s = scr + n * 65 + 16 * c;
        u32x4 o; o.x = pk4_fp8(s[0] * F8_SW, s[1] * F8_SW, s[2] * F8_SW, s[3] * F8_SW); o.y = pk4_fp8(s[4] * F8_SW, s[5] * F8_SW, s[6] * F8_SW, s[7] * F8_SW);
        o.z = pk4_fp8(s[8] * F8_SW, s[9] * F8_SW, s[10] * F8_SW, s[11] * F8_SW); o.w = pk4_fp8(s[12] * F8_SW, s[13] * F8_SW, s[14] * F8_SW, s[15] * F8_SW);
        *(u32x4*)(dst_row0 + (size_t)n * 1024 + k0 + 16 * c) = o; }
    LDS_FENCE();
}
__device__ __forceinline__ void p0_prologue(Ctx& F) {
    {
        LAS float* cond = (LAS float*)F.lds; LAS float* red = cond + 4096;
        for (int i = F.tid; i < 4096; i += 512) { const float v = F.c[i]; cond[i] = v * sigmoidf_(v); }
        __syncthreads();
        float* mod = (float*)(F.ws + WS_MOD);
        for (int u = F.bid; u < 192; u += F.G) {
            const int n0 = u * 32, q = F.tid & 7, kg = F.tid >> 3;
            f32x4 a0 = {0.f, 0.f, 0.f, 0.f}, a1 = a0, a2 = a0, a3 = a0;
#pragma unroll 4
            for (int i = 0; i < 16; ++i) { const int k = kg + 64 * i; const f32x4 w = *(const f32x4*)(F.w_ada + (size_t)k * 6144 + n0 + 4 * q);
                a0 += w * cond[k]; a1 += w * cond[1024 + k]; a2 += w * cond[2048 + k]; a3 += w * cond[3072 + k]; }
            *(LAS f32x4*)(red + kg * 128 + 0 + 4 * q) = a0; *(LAS f32x4*)(red + kg * 128 + 32 + 4 * q) = a1;
            *(LAS f32x4*)(red + kg * 128 + 64 + 4 * q) = a2; *(LAS f32x4*)(red + kg * 128 + 96 + 4 * q) = a3;
            __syncthreads();
            if (F.tid < 128) { float s = 0.f;
                for (int g = 0; g < 64; ++g) s += red[g * 128 + F.tid];
                const int b = F.tid >> 5, col = F.tid & 31; mod[b * 6144 + n0 + col] = s + F.b_ada[n0 + col]; }
            __syncthreads();
        }
        __syncthreads();
    }
    for (int idx = F.bid * 512 + F.tid; idx < 32768; idx += F.G * 512) { const int k = idx >> 5, e = idx & 31; const float w = F.w_router[idx];
        const unsigned hi = pk2(w, 0.f) & 0xffffu; const unsigned lo = pk2(w - bf2f(hi), 0.f) & 0xffffu;
        bf16_t* wrt = (bf16_t*)(F.ws + WS_WRT); wrt[e * 1024 + k] = (bf16_t)hi; wrt[32768 + e * 1024 + k] = (bf16_t)lo; }
    LAS float* scr = (LAS float*)F.lds + F.wave * 2080;
    const int gw = F.bid * 8 + F.wave, NGW = F.G * 8;
    constexpr int I_IN = 16 * 112, I_OUT = 16 * 32, I_GU = 32 * 16 * 64, I_DN = 32 * 16 * 32, NITEMS = I_IN + I_OUT + I_GU + I_DN;
    for (int it = gw; it < NITEMS; it += NGW) {
        int r = it;
        if (r < I_IN) { const int kb = r / 112, nb = r % 112; p0_transpose_item(F.w_in, DIN, kb * 64, nb * 32, (bf16_t*)(F.ws + WS_WIN) + (size_t)(nb * 32) * 1024, scr, F.lane); continue; } r -= I_IN;
        if (r < I_OUT) { const int kb = r / 32, nb = r % 32; p0_transpose_item(F.w_out, D, kb * 64, nb * 32, (bf16_t*)(F.ws + WS_WOUT) + (size_t)(nb * 32) * 1024, scr, F.lane); continue; } r -= I_OUT;
        if (r < I_GU) { const int e = r / 1024, r2 = r % 1024, kb = r2 / 64, nb = r2 % 64; const int n0 = nb * 32;
            const int drow = (n0 < 1024) ? ((n0 >> 7) * 256 + (n0 & 127)) : (((n0 - 1024) >> 7) * 256 + 128 + ((n0 - 1024) & 127));
            if (MOE_FP8) p0_transpose_item8(F.w_gu + (size_t)e * 1024 * 2048, 2048, kb * 64, n0, (unsigned char*)(F.ws + WS_WGU) + ((size_t)e * 2048 + drow) * 1024, scr, F.lane);
            else p0_transpose_item(F.w_gu + (size_t)e * 1024 * 2048, 2048, kb * 64, n0, (bf16_t*)(F.ws + WS_WGU) + ((size_t)e * 2048 + drow) * 1024, scr, F.lane);
            continue; } r -= I_GU;
        { const int e = r / 512, r2 = r % 512, kb = r2 / 32, nb = r2 % 32;
            if (MOE_FP8) p0_transpose_item8(F.w_down + (size_t)e * 1024 * 1024, 1024, kb * 64, nb * 32, (unsigned char*)(F.ws + WS_WDN) + ((size_t)e * 1024 + nb * 32) * 1024, scr, F.lane);
            else p0_transpose_item(F.w_down + (size_t)e * 1024 * 1024, 1024, kb * 64, nb * 32, (bf16_t*)(F.ws + WS_WDN) + ((size_t)e * 1024 + nb * 32) * 1024, scr, F.lane); }
    }
}

__device__ __forceinline__ void p1_norm_mod(Ctx& F) {
    const int gw = F.bid * 8 + F.wave, NGW = F.G * 8;
    const float* mod = (const float*)(F.ws + WS_MOD);
    bf16_t* H = (bf16_t*)(F.ws + WS_H);
    f32x4 nv[4];
    if (gw < T) {
#pragma unroll
        for (int j = 0; j < 4; ++j) nv[j] = ((const f32x4*)(F.x + (size_t)gw * D) + F.lane)[64 * j]; }
    for (int m = gw; m < T; m += NGW) {
        const int b = m / SEQ;
        f32x4 v[4]; float ss = 0.f;
#pragma unroll
        for (int j = 0; j < 4; ++j) { v[j] = nv[j]; ss += (v[j].x * v[j].x + v[j].y * v[j].y) + (v[j].z * v[j].z + v[j].w * v[j].w); }
        if (m + NGW < T) {
#pragma unroll
            for (int j = 0; j < 4; ++j) nv[j] = ((const f32x4*)(F.x + (size_t)(m + NGW) * D) + F.lane)[64 * j]; }
        const float rstd = 1.0f / sqrtf(wave_sum(ss) * (1.f / D) + EPS);
        u32x2* o = (u32x2*)(H + (size_t)m * D) + F.lane;
#pragma unroll
        for (int j = 0; j < 4; ++j) { const int k = 4 * F.lane + 256 * j;
            const f32x4 g = *(const f32x4*)(F.g_pre_mix + k), sh = *(const f32x4*)(mod + b * 6144 + k), sc = *(const f32x4*)(mod + b * 6144 + 1024 + k);
            const f32x4 h = v[j] * rstd * g * (sc + 1.0f) + sh;
            u32x2 w; w.x = pk2(h.x, h.y); w.y = pk2(h.z, h.w); o[64 * j] = w; }
    }
}

constexpr int HG_QE = 0, HG_KE = 8704, HG_KD = 17408, HG_V = 27648, HG_SEG = 37888, HG_DEC = 41984, HG_OP = 42496;
__device__ __forceinline__ void hgrn_local_unit(Ctx& F, int u) {
    const int bh = u >> 4, jj = u & 15, b = bh >> 2, h = bh & 3;
    const int rowbase = b * SEQ + jj * 256;
    const bf16_t* proj = (const bf16_t*)(F.ws + WS_PROJ);
    bf16_t* QE = (bf16_t*)(F.ws + WS_QE); bf16_t* OLOC = (bf16_t*)(F.ws + WS_OLOC);
    LAS unsigned char* L = F.lds;
    const int seg = F.wave, dp = F.lane;
    const int eb = F.wave & 3, dh = F.wave >> 2, c32 = F.lane & 31, hh = F.lane >> 5;
    const int i16 = F.lane & 15, tq = i16 >> 2, tp = i16 & 3, blk = (F.lane >> 4) & 1;
    float lbv[2], oml[2], ecum[2] = {1.f, 1.f};
#pragma unroll
    for (int dd = 0; dd < 2; ++dd) { const int d = h * 128 + 2 * dp + dd; const float a0 = F.hgrn_lb[d], a1 = F.hgrn_lb[512 + d]; lbv[dd] = 1.f / (1.f + __expf(a1 - a0)); oml[dd] = 1.f - lbv[dd]; }
    f32x16 Sacc[2];
#pragma unroll
    for (int i = 0; i < 2; ++i)
#pragma unroll
        for (int r = 0; r < 16; ++r) Sacc[i][r] = 0.f;
    LAS float* segtot = (LAS float*)(L + HG_SEG); LAS float* dec = (LAS float*)(L + HG_DEC); LAS float* op = (LAS float*)(L + HG_OP);
    unsigned nfr[4], nqr[4], nv2[4];
#pragma unroll
    for (int i = 0; i < 4; ++i) { const bf16_t* rp = proj + (size_t)(rowbase + 4 * seg + i) * DIN + h * 128 + 2 * dp;
        nfr[i] = *(const unsigned*)(rp + C_FR); nqr[i] = *(const unsigned*)(rp + C_QR); nv2[i] = *(const unsigned*)(rp + C_IR); }
    for (int sc = 0; sc < 8; ++sc) {
        const int row0 = rowbase + sc * 32;
        unsigned fr2[4], qr2[4], v2[4];
#pragma unroll
        for (int i = 0; i < 4; ++i) { fr2[i] = nfr[i]; qr2[i] = nqr[i]; v2[i] = nv2[i]; }
        if (sc < 7) {
#pragma unroll
            for (int i = 0; i < 4; ++i) { const bf16_t* rp = proj + (size_t)(row0 + 32 + 4 * seg + i) * DIN + h * 128 + 2 * dp;
                nfr[i] = *(const unsigned*)(rp + C_FR); nqr[i] = *(const unsigned*)(rp + C_QR); nv2[i] = *(const unsigned*)(rp + C_IR); } }
        float Pc[4][2], kk[4][2], qq[4][2], run[2] = {1.f, 1.f};
#pragma unroll
        for (int i = 0; i < 4; ++i)
#pragma unroll
            for (int dd = 0; dd < 2; ++dd) {
                const float fr = dd ? bfhi(fr2[i]) : bflo(fr2[i]); const float qr = dd ? bfhi(qr2[i]) : bflo(qr2[i]);
                const float sg = sigmoidf_(fr); const float f = lbv[dd] + oml[dd] * sg;
                kk[i][dd] = oml[dd] * (1.f - sg); run[dd] *= f; Pc[i][dd] = run[dd]; qq[i][dd] = qr * sigmoidf_(qr); }
        *(LAS f32x2*)(segtot + seg * 128 + 2 * dp) = (f32x2){run[0], run[1]};
        __syncthreads();
        float pre[2] = {1.f, 1.f}, tot[2] = {1.f, 1.f};
#pragma unroll
        for (int s = 0; s < 8; ++s) { const f32x2 t2 = *(const LAS f32x2*)(segtot + s * 128 + 2 * dp);
            pre[0] *= (s < seg) ? t2.x : 1.f; pre[1] *= (s < seg) ? t2.y : 1.f; tot[0] *= t2.x; tot[1] *= t2.y; }
#pragma unroll
        for (int i = 0; i < 4; ++i) { const int trow = 4 * seg + i; float qe[2], ke[2], kd[2];
#pragma unroll
            for (int dd = 0; dd < 2; ++dd) { const float Eb = pre[dd] * Pc[i][dd]; const float inv = 1.f / Eb; qe[dd] = qq[i][dd] * Eb; ke[dd] = kk[i][dd] * inv; kd[dd] = ke[dd] * tot[dd]; }
            *(LAS unsigned*)(L + HG_QE + trow * 272 + 4 * dp) = pk2(qe[0], qe[1]);
            *(LAS unsigned*)(L + HG_KE + trow * 272 + 4 * dp) = pk2(ke[0], ke[1]);
            *(LAS unsigned*)(L + HG_KD + trow * 320 + 4 * dp) = pk2(kd[0], kd[1]);
            *(LAS unsigned*)(L + HG_V + trow * 320 + 4 * dp) = v2[i];
            *(unsigned*)(QE + (size_t)(row0 + trow) * 512 + h * 128 + 2 * dp) = pk2(qe[0] * ecum[0], qe[1] * ecum[1]); }
        if (seg == 0) *(LAS f32x2*)(dec + 2 * dp) = (f32x2){tot[0], tot[1]};
        ecum[0] *= tot[0]; ecum[1] *= tot[1];
        __syncthreads();
        f32x16 X;
#pragma unroll
        for (int r = 0; r < 16; ++r) X[r] = 0.f;
#pragma unroll
        for (int k = 0; k < 4; ++k) { const int dofs = (64 * dh + 16 * k + 8 * hh) * 2;
            const bf16x8 a = *(const LAS bf16x8*)(L + HG_KE + c32 * 272 + dofs); const bf16x8 bq = *(const LAS bf16x8*)(L + HG_QE + c32 * 272 + dofs);
            X = MFMA32(a, bq, X); }
#pragma unroll
        for (int r = 0; r < 16; ++r) X[r] = (crow(r, hh) <= c32) ? X[r] : 0.f;
        f32x16 O;
#pragma unroll
        for (int r = 0; r < 16; ++r) O[r] = 0.f;
#pragma unroll
        for (int s2 = 0; s2 < 2; ++s2) { const LAS unsigned char* vb = L + HG_V + (16 * s2 + 4 * hh + tq) * 320 + (32 * eb + 16 * blk + 4 * tp) * 2;
            const bf16x8 a2 = cat8(tr_read(vb), tr_read(vb + 8 * 320)); O = MFMA32(a2, pack_step(X, s2), O); }
#pragma unroll
        for (int i = 0; i < 2; ++i)
#pragma unroll
            for (int s3 = 0; s3 < 2; ++s3) { const LAS unsigned char* qb = L + HG_QE + c32 * 272 + (32 * (2 * dh + i) + 16 * s3 + 4 * hh) * 2;
                const s16x4 lo = *(const LAS s16x4*)qb, hi = *(const LAS s16x4*)(qb + 16);
                O = MFMA32(pack_step(Sacc[i], s3), cat8(lo, hi), O); }
#pragma unroll
        for (int i = 0; i < 2; ++i) { const int dblk = 2 * dh + i;
#pragma unroll
            for (int r = 0; r < 16; ++r) Sacc[i][r] *= dec[32 * dblk + crow(r, hh)];
#pragma unroll
            for (int st = 0; st < 2; ++st) { const LAS unsigned char* ka = L + HG_KD + (16 * st + 8 * hh + tq) * 320 + (32 * dblk + 16 * blk + 4 * tp) * 2;
                const LAS unsigned char* va = L + HG_V + (16 * st + 8 * hh + tq) * 320 + (32 * eb + 16 * blk + 4 * tp) * 2;
                const bf16x8 a4 = cat8(tr_read(ka), tr_read(ka + 4 * 320)); const bf16x8 b4 = cat8(tr_read(va), tr_read(va + 4 * 320));
                Sacc[i] = MFMA32(a4, b4, Sacc[i]); } }
        if (dh == 1) {
#pragma unroll
            for (int r = 0; r < 16; ++r) op[(eb * 16 + r) * 64 + F.lane] = O[r]; }
        __syncthreads();
        if (dh == 0) {
#pragma unroll
            for (int r = 0; r < 16; ++r) O[r] += op[(eb * 16 + r) * 64 + F.lane];
            bf16_t* orow = OLOC + (size_t)(row0 + c32) * 512 + h * 128 + 32 * eb + 4 * hh;
#pragma unroll
            for (int g = 0; g < 4; ++g) { u32x2 w; w.x = pk2(O[4 * g], O[4 * g + 1]); w.y = pk2(O[4 * g + 2], O[4 * g + 3]); *(u32x2*)(orow + 8 * g) = w; } }
    }
    float* SL = (float*)(F.ws + WS_SLOC) + (size_t)u * 16384;
#pragma unroll
    for (int i = 0; i < 2; ++i)
#pragma unroll
        for (int r = 0; r < 16; ++r) SL[(32 * (2 * dh + i) + crow(r, hh)) * 128 + 32 * eb + c32] = Sacc[i][r];
    if (seg == 0) *(f32x2*)((float*)(F.ws + WS_DTOT) + u * 128 + 2 * dp) = (f32x2){ecum[0], ecum[1]};
    __syncthreads();
}

constexpr int AT_KS = 144, AT_VS = 192, AT_K = 0, AT_V = 384 * 144;
struct AttnU { int n, dil, r, p, b, h; };
__device__ __forceinline__ AttnU attn_decode(int u) {
    AttnU a; a.n = u >> 9; const int rem = u & 511, bh = rem >> 4;
    if (a.n == 0) { a.dil = 1; a.p = rem & 15; a.r = 0; } else if (a.n == 1) { a.dil = 4; a.r = (rem >> 2) & 3; a.p = rem & 3; } else { a.dil = 16; a.r = rem & 15; a.p = 0; }
    a.b = bh >> 3; a.h = bh & 7; return a;
}
__device__ __forceinline__ void attn_load(Ctx& F, const AttnU& a, u32x4 (&kv)[12], bf16x8 (&qf)[4]) {
    const bf16_t* proj = (const bf16_t*)(F.ws + WS_PROJ);
#pragma unroll
    for (int it = 0; it < 12; ++it) { const int idx = F.tid + 512 * (it % 6); const int row = idx >> 3, pc = idx & 7; const int sub = 256 * a.p - 128 + row;
        const int subc = sub < 0 ? 0 : sub;
        const bf16_t* src = proj + (size_t)(a.b * SEQ + subc * a.dil + a.r) * DIN + (it < 6 ? C_KA : C_VA) + a.h * 64 + pc * 8;
        kv[it] = *(const u32x4*)src; }
    const int qsub = 256 * a.p + 32 * F.wave + (F.lane & 31); const size_t grow = (size_t)a.b * SEQ + (size_t)qsub * a.dil + a.r;
#pragma unroll
    for (int k = 0; k < 4; ++k) qf[k] = *(const bf16x8*)(proj + grow * DIN + C_QA + a.h * 64 + 16 * k + 8 * (F.lane >> 5));
}
__device__ __forceinline__ void attn_stage(Ctx& F, const AttnU& a, const u32x4 (&kv)[12]) {
    LAS unsigned char* L = F.lds;
#pragma unroll
    for (int it = 0; it < 12; ++it) { const int idx = F.tid + 512 * (it % 6); const int row = idx >> 3, pc = idx & 7; const int sub = 256 * a.p - 128 + row;
        const u32x4 v = (sub < 0) ? (u32x4){0u, 0u, 0u, 0u} : kv[it];
        if (it < 6) *(LAS u32x4*)(L + AT_K + row * AT_KS + pc * 16) = v; else *(LAS u32x4*)(L + AT_V + row * AT_VS + pc * 16) = v; }
}
__device__ __forceinline__ void attn_compute(Ctx& F, const AttnU& a, const bf16x8 (&qf)[4]) {
    LAS unsigned char* L = F.lds;
    const int w = F.wave, c32 = F.lane & 31, hh = F.lane >> 5;
    const int i16 = F.lane & 15, tq = i16 >> 2, tp = i16 & 3, blk = (F.lane >> 4) & 1;
    const int n = a.n, p = a.p, h = a.h;
    const int qsub = 256 * p + 32 * w + c32; const size_t grow = (size_t)a.b * SEQ + (size_t)qsub * a.dil + a.r;
    const int kb0 = (p == 0 && w < 4) ? (4 - w) : 0;
    f32x16 X[5];
#pragma unroll
    for (int kb = 0; kb < 5; ++kb) {
#pragma unroll
        for (int r16 = 0; r16 < 16; ++r16) X[kb][r16] = 0.f;
        if (kb >= kb0) {
#pragma unroll
            for (int k = 0; k < 4; ++k) { const bf16x8 af = *(const LAS bf16x8*)(L + AT_K + (32 * (w + kb) + c32) * AT_KS + (16 * k + 8 * hh) * 2); X[kb] = MFMA32(af, qf[k], X[kb]); } }
    }
    float m = -INFINITY;
#pragma unroll
    for (int kb = 0; kb < 5; ++kb)
#pragma unroll
        for (int r16 = 0; r16 < 16; ++r16) { const int row = crow(r16, hh);
            bool valid = (kb >= kb0); if (kb == 0) valid = valid && (row >= c32); if (kb == 4) valid = valid && (row <= c32);
            X[kb][r16] = valid ? X[kb][r16] : -INFINITY; m = fmaxf(m, X[kb][r16]); }
    m = fmaxf(m, __shfl_xor(m, 32));
    const float c2 = 0.125f * 1.4426950408889634f;
    float l = 0.f;
#pragma unroll
    for (int kb = 0; kb < 5; ++kb)
#pragma unroll
        for (int r16 = 0; r16 < 16; ++r16) { const float pv = __builtin_amdgcn_exp2f((X[kb][r16] - m) * c2); X[kb][r16] = pv; l += pv; }
    l += __shfl_xor(l, 32);
    f32x16 O[2];
#pragma unroll
    for (int i = 0; i < 2; ++i)
#pragma unroll
        for (int r16 = 0; r16 < 16; ++r16) O[i][r16] = 0.f;
#pragma unroll
    for (int kb = 0; kb < 5; ++kb) {
        if (kb >= kb0) {
#pragma unroll
            for (int s = 0; s < 2; ++s) { const bf16x8 pb = pack_step(X[kb], s);
#pragma unroll
                for (int dhf = 0; dhf < 2; ++dhf) { const LAS unsigned char* vb = L + AT_V + (32 * (w + kb) + 16 * s + 4 * hh + tq) * AT_VS + (32 * dhf + 16 * blk + 4 * tp) * 2;
                    const bf16x8 af = cat8(tr_read(vb), tr_read(vb + 8 * AT_VS)); O[dhf] = MFMA32(af, pb, O[dhf]); } } }
    }
    const float inv = rcpf_(l);
    bf16_t* po = (bf16_t*)(F.ws + WS_PARTO) + ((size_t)n * T + grow) * 512 + h * 64 + 4 * hh;
#pragma unroll
    for (int dhf = 0; dhf < 2; ++dhf)
#pragma unroll
        for (int g = 0; g < 4; ++g) { u32x2 wv; wv.x = pk2(O[dhf][4 * g] * inv, O[dhf][4 * g + 1] * inv); wv.y = pk2(O[dhf][4 * g + 2] * inv, O[dhf][4 * g + 3] * inv);
            *(u32x2*)(po + 32 * dhf + 8 * g) = wv; }
    if (hh == 0) ((float*)(F.ws + WS_LSE))[((size_t)n * T + grow) * 8 + h] = m * 0.125f + __logf(l);
}
__device__ __forceinline__ void attn_units(Ctx& F) {
    int u = F.bid; if (u >= 1536) return;
    u32x4 kv[12]; bf16x8 qf[4], qn[4];
    AttnU a = attn_decode(u);
    attn_load(F, a, kv, qn);
    for (; u < 1536; u += F.G) {
        attn_stage(F, a, kv);
#pragma unroll
        for (int k = 0; k < 4; ++k) qf[k] = qn[k];
        __syncthreads();
        const AttnU cur = a;
        if (u + F.G < 1536) { a = attn_decode(u + F.G); attn_load(F, a, kv, qn); }
        attn_compute(F, cur, qf);
        __syncthreads();
    }
}

__device__ __forceinline__ void p4_scan(Ctx& F) {
    const float* SL = (const float*)(F.ws + WS_SLOC); const float* DT = (const float*)(F.ws + WS_DTOT); bf16_t* SIN = (bf16_t*)(F.ws + WS_SIN);
    for (int unit = F.bid; unit < 256; unit += F.G) {
        const int bh = unit >> 4, bk = unit & 15, db = bk >> 2, ebk = bk & 3;
        const int e = 32 * ebk + (F.tid & 31), d0 = 32 * db + (F.tid >> 5), d1 = d0 + 16;
        float s0 = 0.f, s1 = 0.f;
        for (int j = 0; j < 16; ++j) { const int u = bh * 16 + j;
            SIN[(size_t)u * 16384 + d0 * 128 + e] = (bf16_t)(pk2(s0, 0.f) & 0xffffu); SIN[(size_t)u * 16384 + d1 * 128 + e] = (bf16_t)(pk2(s1, 0.f) & 0xffffu);
            s0 = DT[u * 128 + d0] * s0 + SL[(size_t)u * 16384 + d0 * 128 + e]; s1 = DT[u * 128 + d1] * s1 + SL[(size_t)u * 16384 + d1 * 128 + e]; }
    }
}

__device__ __forceinline__ void p5_fixup_unit(Ctx& F, int u) {
    const int bh = u >> 4, jj = u & 15, b = bh >> 2, h = bh & 3;
    const int rowbase = b * SEQ + jj * 256;
    LAS unsigned char* L = F.lds;
    const bf16_t* SIN = (const bf16_t*)(F.ws + WS_SIN) + (size_t)u * 16384;
    const bf16_t* QE = (const bf16_t*)(F.ws + WS_QE); const bf16_t* OLOC = (const bf16_t*)(F.ws + WS_OLOC); const bf16_t* proj = (const bf16_t*)(F.ws + WS_PROJ);
    bf16_t* YC = (bf16_t*)(F.ws + WS_YCAT);
    const int c32 = F.lane & 31, hh = F.lane >> 5, i16 = F.lane & 15, tq = i16 >> 2, tp = i16 & 3, blk = (F.lane >> 4) & 1;
#pragma unroll
    for (int it = 0; it < 4; ++it) { const int idx = F.tid + 512 * it, row = idx >> 4, pc = idx & 15; *(LAS u32x4*)(L + row * 320 + pc * 16) = *(const u32x4*)(SIN + row * 128 + pc * 8); }
    const size_t tok = (size_t)rowbase + 32 * F.wave + c32;
    bf16x8 bq[8];
#pragma unroll
    for (int k = 0; k < 8; ++k) bq[k] = *(const bf16x8*)(QE + tok * 512 + h * 128 + 16 * k + 8 * hh);
    __syncthreads();
    f32x16 acc[4];
#pragma unroll
    for (int et = 0; et < 4; ++et) {
#pragma unroll
        for (int r = 0; r < 16; ++r) acc[et][r] = 0.f;
#pragma unroll
        for (int k = 0; k < 8; ++k) { const LAS unsigned char* sb = L + (16 * k + 8 * hh + tq) * 320 + (32 * et + 16 * blk + 4 * tp) * 2;
            const bf16x8 a = cat8(tr_read(sb), tr_read(sb + 4 * 320)); acc[et] = MFMA32(a, bq[k], acc[et]); }
    }
    float ss = 0.f;
#pragma unroll
    for (int et = 0; et < 4; ++et)
#pragma unroll
        for (int g = 0; g < 4; ++g) { const int e0 = 32 * et + 8 * g + 4 * hh; const u32x2 ol = *(const u32x2*)(OLOC + tok * 512 + h * 128 + e0);
            acc[et][4 * g] += bflo(ol.x); acc[et][4 * g + 1] += bfhi(ol.x); acc[et][4 * g + 2] += bflo(ol.y); acc[et][4 * g + 3] += bfhi(ol.y);
            ss += (acc[et][4 * g] * acc[et][4 * g] + acc[et][4 * g + 1] * acc[et][4 * g + 1]) + (acc[et][4 * g + 2] * acc[et][4 * g + 2] + acc[et][4 * g + 3] * acc[et][4 * g + 3]); }
    ss += __shfl_xor(ss, 32);
    const float rstd = 1.0f / sqrtf(ss * (1.f / 128.f) + EPS);
#pragma unroll
    for (int et = 0; et < 4; ++et)
#pragma unroll
        for (int g = 0; g < 4; ++g) { const int e0 = 32 * et + 8 * g + 4 * hh; const f32x4 nw = *(const f32x4*)(F.hgrn_norm_w + h * 128 + e0);
            const u32x2 g2 = *(const u32x2*)(proj + tok * DIN + C_GR + h * 128 + e0);
            const float ga = bflo(g2.x), gb = bfhi(g2.x), gc = bflo(g2.y), gd = bfhi(g2.y);
            u32x2 wv; wv.x = pk2(acc[et][4 * g] * rstd * nw.x * (ga * sigmoidf_(ga)), acc[et][4 * g + 1] * rstd * nw.y * (gb * sigmoidf_(gb)));
            wv.y = pk2(acc[et][4 * g + 2] * rstd * nw.z * (gc * sigmoidf_(gc)), acc[et][4 * g + 3] * rstd * nw.w * (gd * sigmoidf_(gd)));
            *(u32x2*)(YC + tok * 1024 + 512 + h * 128 + e0) = wv; }
    __syncthreads();
}
__device__ __forceinline__ void p5_attn_merge(Ctx& F) {
    const int gw = F.bid * 8 + F.wave, NGW = F.G * 8;
    const bf16_t* PO = (const bf16_t*)(F.ws + WS_PARTO); const float* LS = (const float*)(F.ws + WS_LSE); bf16_t* YC = (bf16_t*)(F.ws + WS_YCAT);
    const int hd = F.lane >> 3, sub = F.lane & 7;
#pragma unroll 2
    for (int tok = gw; tok < T; tok += NGW) {
        float ls[3]; u32x4 o[3];
#pragma unroll
        for (int n = 0; n < 3; ++n) { ls[n] = LS[((size_t)n * T + tok) * 8 + hd]; o[n] = *(const u32x4*)(PO + ((size_t)n * T + tok) * 512 + hd * 64 + sub * 8); }
        const float mx = fmaxf(ls[0], fmaxf(ls[1], ls[2]));
        float wgt[3]; wgt[0] = __expf(ls[0] - mx); wgt[1] = __expf(ls[1] - mx); wgt[2] = __expf(ls[2] - mx);
        const float inv = 1.f / (wgt[0] + wgt[1] + wgt[2]);
        float v[8];
#pragma unroll
        for (int i = 0; i < 8; ++i) v[i] = 0.f;
#pragma unroll
        for (int n = 0; n < 3; ++n) { const float wn = wgt[n] * inv;
            v[0] += wn * bflo(o[n].x); v[1] += wn * bfhi(o[n].x); v[2] += wn * bflo(o[n].y); v[3] += wn * bfhi(o[n].y);
            v[4] += wn * bflo(o[n].z); v[5] += wn * bfhi(o[n].z); v[6] += wn * bflo(o[n].w); v[7] += wn * bfhi(o[n].w); }
        float ss = 0.f;
#pragma unroll
        for (int i = 0; i < 8; ++i) ss += v[i] * v[i];
        ss += __shfl_xor(ss, 1); ss += __shfl_xor(ss, 2); ss += __shfl_xor(ss, 4);
        const float rstd = 1.0f / sqrtf(ss * (1.f / 64.f) + EPS);
        const f32x4 n0 = *(const f32x4*)(F.attn_norm_w + hd * 64 + sub * 8), n1 = *(const f32x4*)(F.attn_norm_w + hd * 64 + sub * 8 + 4);
        u32x4 wv; wv.x = pk2(v[0] * rstd * n0.x, v[1] * rstd * n0.y); wv.y = pk2(v[2] * rstd * n0.z, v[3] * rstd * n0.w);
        wv.z = pk2(v[4] * rstd * n1.x, v[5] * rstd * n1.y); wv.w = pk2(v[6] * rstd * n1.z, v[7] * rstd * n1.w);
        *(u32x4*)(YC + (size_t)tok * 1024 + hd * 64 + sub * 8) = wv;
    }
}

__device__ __forceinline__ void p7_load(Ctx& F, int m, u32x2 (&yb)[4], f32x4 (&xv)[4]) {
    const u32x2* yr = (const u32x2*)((const bf16_t*)(F.ws + WS_Y) + (size_t)m * D) + F.lane;
    const f32x4* xr = (const f32x4*)(F.x + (size_t)m * D) + F.lane;
#pragma unroll
    for (int j = 0; j < 4; ++j) { yb[j] = yr[64 * j]; xv[j] = xr[64 * j]; }
}
__device__ __forceinline__ void p7_row(Ctx& F, int m, const u32x2 (&yb)[4], f32x4 (&xv)[4]) {
    const float* mod = (const float*)(F.ws + WS_MOD); const int b = m / SEQ;
    f32x4 y[4]; float ss = 0.f;
#pragma unroll
    for (int j = 0; j < 4; ++j) { y[j] = (f32x4){bflo(yb[j].x), bfhi(yb[j].x), bflo(yb[j].y), bfhi(yb[j].y)};
        ss += (y[j].x * y[j].x + y[j].y * y[j].y) + (y[j].z * y[j].z + y[j].w * y[j].w); }
    const float rstd1 = 1.0f / sqrtf(wave_sum(ss) * (1.f / D) + EPS);
    f32x4* x2o = (f32x4*)((float*)(F.ws + WS_X2) + (size_t)m * D) + F.lane;
    float ss2 = 0.f;
#pragma unroll
    for (int j = 0; j < 4; ++j) { const int k = 4 * F.lane + 256 * j;
        const f32x4 gp = *(const f32x4*)(F.g_post_mix + k), gm = *(const f32x4*)(mod + b * 6144 + 2048 + k);
        xv[j] = xv[j] + gm * (y[j] * rstd1 * gp); x2o[64 * j] = xv[j];
        ss2 += (xv[j].x * xv[j].x + xv[j].y * xv[j].y) + (xv[j].z * xv[j].z + xv[j].w * xv[j].w); }
    const float rstd2 = 1.0f / sqrtf(wave_sum(ss2) * (1.f / D) + EPS);
    u32x2* ho = (u32x2*)((bf16_t*)(F.ws + WS_H) + (size_t)m * D) + F.lane;
    u32x2* hl = (u32x2*)((bf16_t*)(F.ws + WS_HLO) + (size_t)m * D) + F.lane;
#pragma unroll
    for (int j = 0; j < 4; ++j) { const int k = 4 * F.lane + 256 * j;
        const f32x4 g = *(const f32x4*)(F.g_pre_ffn + k), sh = *(const f32x4*)(mod + b * 6144 + 3072 + k), sc = *(const f32x4*)(mod + b * 6144 + 4096 + k);
        const f32x4 hx = xv[j] * rstd2 * g * (sc + 1.0f) + sh;
        u32x2 w; w.x = pk2(hx.x, hx.y); w.y = pk2(hx.z, hx.w); ho[64 * j] = w;
        u32x2 l; l.x = pk2(hx.x - bflo(w.x), hx.y - bfhi(w.x)); l.y = pk2(hx.z - bflo(w.y), hx.w - bfhi(w.y)); hl[64 * j] = l;
        if (MOE_FP8) ((unsigned*)((unsigned char*)(F.ws + WS_H8) + (size_t)m * D) + F.lane)[64 * j] = pk4_fp8(hx.x * F8_SA, hx.y * F8_SA, hx.z * F8_SA, hx.w * F8_SA); }
}
__device__ __forceinline__ void p7_rows(Ctx& F) {
    LAS float* part = (LAS float*)F.lds;
    LAS int* hist = (LAS int*)(F.lds + MISC_OFF); LAS int* gbase = hist + 32; LAS int* pbp = hist + 64; LAS int* pbe = hist + 64 + 256; LAS float* pbg = (LAS float*)(hist + 64 + 512);
    unsigned* cnt = (unsigned*)(F.ws + WS_CTL) + CW_CNT; u32x2* TOK = (u32x2*)(F.ws + WS_TOK);
    const bf16_t* H = (const bf16_t*)(F.ws + WS_H); const bf16_t* HLO = (const bf16_t*)(F.ws + WS_HLO); const bf16_t* WRT = (const bf16_t*)(F.ws + WS_WRT);
    const int c32 = F.lane & 31, hh = F.lane >> 5, tt = F.wave & 1, kq = F.wave >> 1;
    for (int rb = F.bid; rb < T / 64; rb += F.G) {
        if (F.tid < 32) hist[F.tid] = 0;
        { u32x2 nyb[4]; f32x4 nxv[4]; p7_load(F, rb * 64 + F.wave * 8, nyb, nxv);
          for (int i = 0; i < 8; ++i) { u32x2 yb[4]; f32x4 xv[4];
#pragma unroll
              for (int j = 0; j < 4; ++j) { yb[j] = nyb[j]; xv[j] = nxv[j]; }
              if (i < 7) p7_load(F, rb * 64 + F.wave * 8 + i + 1, nyb, nxv);
              p7_row(F, rb * 64 + F.wave * 8 + i, yb, xv); } }
        asm volatile("s_waitcnt vmcnt(0)" ::: "memory");
        __syncthreads();
        const size_t tok = (size_t)rb * 64 + 32 * tt + c32;
        f32x16 acc;
#pragma unroll
        for (int r = 0; r < 16; ++r) acc[r] = 0.f;
#pragma unroll 4
        for (int s = 0; s < 16; ++s) { const int k0 = 256 * kq + 16 * s + 8 * hh;
            const bf16x8 bh = *(const bf16x8*)(H + tok * 1024 + k0), bl = *(const bf16x8*)(HLO + tok * 1024 + k0);
            const bf16x8 ah = *(const bf16x8*)(WRT + c32 * 1024 + k0), al = *(const bf16x8*)(WRT + 32768 + c32 * 1024 + k0);
            acc = MFMA32(ah, bh, acc); acc = MFMA32(ah, bl, acc); acc = MFMA32(al, bh, acc); }
#pragma unroll
        for (int r = 0; r < 16; ++r) part[(F.wave * 16 + r) * 64 + F.lane] = acc[r];
        __syncthreads();
        if (kq == 0) {
            float v[16];
#pragma unroll
            for (int r = 0; r < 16; ++r) v[r] = part[((0 * 2 + tt) * 16 + r) * 64 + F.lane] + part[((1 * 2 + tt) * 16 + r) * 64 + F.lane] + part[((2 * 2 + tt) * 16 + r) * 64 + F.lane] + part[((3 * 2 + tt) * 16 + r) * 64 + F.lane] + F.b_router[crow(r, hh)];
            float cv[8]; int ci[8];
#pragma unroll
            for (int kk = 0; kk < 4; ++kk) { float best = -INFINITY; int bi = 0;
#pragma unroll
                for (int r = 0; r < 16; ++r) { const bool gt = v[r] > best; best = gt ? v[r] : best; bi = gt ? crow(r, hh) : bi; }
                cv[kk] = best; ci[kk] = bi;
#pragma unroll
                for (int r = 0; r < 16; ++r) v[r] = (crow(r, hh) == bi) ? -INFINITY : v[r]; }
#pragma unroll
            for (int kk = 0; kk < 4; ++kk) { cv[4 + kk] = __shfl_xor(cv[kk], 32); ci[4 + kk] = __shfl_xor(ci[kk], 32); }
            float val[4]; int idx[4];
#pragma unroll
            for (int kk = 0; kk < 4; ++kk) { float best = -INFINITY; int bi = 1 << 20;
#pragma unroll
                for (int q = 0; q < 8; ++q) { const bool gt = (cv[q] > best) || (cv[q] == best && ci[q] < bi); best = gt ? cv[q] : best; bi = gt ? ci[q] : bi; }
                val[kk] = best; idx[kk] = bi;
#pragma unroll
                for (int q = 0; q < 8; ++q) cv[q] = (ci[q] == bi) ? -INFINITY : cv[q]; }
            float g[4]; float sg = 0.f;
#pragma unroll
            for (int kk = 0; kk < 4; ++kk) { g[kk] = __expf(val[kk] - val[0]); sg += g[kk]; }
            const float inv = 1.f / sg;
            if (hh == 0) { const int mloc = 32 * tt + c32; const int m = rb * 64 + mloc;
#pragma unroll
                for (int kk = 0; kk < 4; ++kk) { const int rank = atomicAdd((int*)(hist + idx[kk]), 1); const int slot = mloc * 4 + kk;
                    pbp[slot] = m * 4 + kk; pbe[slot] = idx[kk] | (rank << 8); pbg[slot] = g[kk] * inv; } }
        }
        __syncthreads();
        if (F.tid < 32) gbase[F.tid] = (int)atomicAdd(cnt + 64 * F.tid, (unsigned)hist[F.tid]);
        __syncthreads();
        if (F.tid < 256) { const int e = pbe[F.tid] & 255, rank = pbe[F.tid] >> 8; TOK[e * LIST_CAP + gbase[e] + rank] = (u32x2){(unsigned)pbp[F.tid], __float_as_uint(pbg[F.tid])}; }
        __syncthreads();
    }
}

__device__ __forceinline__ void moe_tables(Ctx& F, LAS int* cntl, LAS int* tbase, LAS int* sorted_e) {
    const unsigned* cnt = (const unsigned*)(F.ws + WS_CTL) + CW_CNT;
    if (F.tid < NE) cntl[F.tid] = (int)__hip_atomic_load(cnt + 64 * F.tid, __ATOMIC_RELAXED, __HIP_MEMORY_SCOPE_AGENT);
    __syncthreads();
    if (F.tid <= NE) { int base = 0;
        for (int e = 0; e < F.tid; ++e) base += (cntl[e] + 255) >> 8;
        tbase[F.tid] = base; }
    if (F.tid < NE) { const int mine = (cntl[F.tid] + 255) >> 8; int rk = 0;
        for (int e = 0; e < NE; ++e) { const int o = (cntl[e] + 255) >> 8; rk += (o > mine || (o == mine && e < F.tid)) ? 1 : 0; }
        sorted_e[rk] = F.tid; }
    __syncthreads();
}

__device__ __forceinline__ void p10_load(Ctx& F, int m, u32x2 (&yp)[4][4], f32x4 (&xv)[4]) {
    const bf16_t* YP = (const bf16_t*)(F.ws + WS_YPAIR); const float* X2 = (const float*)(F.ws + WS_X2);
#pragma unroll
    for (int j = 0; j < 4; ++j) {
#pragma unroll
        for (int kk = 0; kk < 4; ++kk) yp[j][kk] = *((const u32x2*)(YP + ((size_t)m * 4 + kk) * 1024) + F.lane + 64 * j);
        xv[j] = ((const f32x4*)(X2 + (size_t)m * D) + F.lane)[64 * j]; }
}
__device__ __forceinline__ void p10_final(Ctx& F) {
    const int gw = F.bid * 8 + F.wave, NGW = F.G * 8;
    const float* mod = (const float*)(F.ws + WS_MOD);
    u32x2 nyp[4][4]; f32x4 nxv[4];
    if (gw < T) p10_load(F, gw, nyp, nxv);
    for (int m = gw; m < T; m += NGW) {
        const int b = m / SEQ;
        f32x4 y[4], xv[4]; float ss = 0.f;
#pragma unroll
        for (int j = 0; j < 4; ++j) { y[j] = (f32x4){0.f, 0.f, 0.f, 0.f}; xv[j] = nxv[j];
#pragma unroll
            for (int kk = 0; kk < 4; ++kk) { const u32x2 v = nyp[j][kk]; y[j].x += bflo(v.x); y[j].y += bfhi(v.x); y[j].z += bflo(v.y); y[j].w += bfhi(v.y); }
            ss += (y[j].x * y[j].x + y[j].y * y[j].y) + (y[j].z * y[j].z + y[j].w * y[j].w); }
        if (m + NGW < T) p10_load(F, m + NGW, nyp, nxv);
        const float rstd = 1.0f / sqrtf(wave_sum(ss) * (1.f / D) + EPS);
        f32x4* o = (f32x4*)(F.out + (size_t)m * D) + F.lane;
#pragma unroll
        for (int j = 0; j < 4; ++j) { const int k = 4 * F.lane + 256 * j;
            const f32x4 gp = *(const f32x4*)(F.g_post_ffn + k), gf = *(const f32x4*)(mod + b * 6144 + 5120 + k);
            o[64 * j] = xv[j] + gf * (y[j] * rstd * gp); }
    }
}

struct Args { const float* in[19]; float* out; unsigned char* ws; int ph_lo, ph_hi; };
__global__ void __launch_bounds__(512, 2) fwd(Args args) {
    extern __shared__ __attribute__((aligned(16))) unsigned char lds_raw[];
    Ctx F;
    F.lds = (LAS unsigned char*)lds_raw;
    F.tid = threadIdx.x; F.lane = F.tid & 63; F.wave = __builtin_amdgcn_readfirstlane(F.tid >> 6); F.G = gridDim.x; F.bid = blockIdx.x;
    F.x = args.in[0]; F.c = args.in[1]; F.w_ada = args.in[2]; F.b_ada = args.in[3]; F.g_pre_mix = args.in[4]; F.g_post_mix = args.in[5]; F.w_in = args.in[6];
    F.attn_norm_w = args.in[7]; F.hgrn_lb = args.in[8]; F.hgrn_norm_w = args.in[9]; F.w_out = args.in[10]; F.g_pre_ffn = args.in[11]; F.g_post_ffn = args.in[12];
    F.w_router = args.in[13]; F.b_router = args.in[14]; F.w_gu = args.in[15]; F.b_gu = args.in[16]; F.w_down = args.in[17]; F.b_down = args.in[18];
    F.out = args.out; F.ws = args.ws;
    volatile LAS unsigned* barw = (volatile LAS unsigned*)(F.lds + BARW_OFF);
    if (F.tid < 4) barw[F.tid] = 0u;
    __syncthreads();
    XcdBarrier bar; bar.bar = (unsigned*)(F.ws + WS_CTL) + CW_BAR; bar.x = 0; bar.st = barw;
    if (MK_N_LAUNCHES == 1) bar = xcd_barrier_post((unsigned*)(F.ws + WS_CTL) + CW_BAR, barw);
    const int lo = args.ph_lo, hi = args.ph_hi;
#ifndef PH_MASK
#define PH_MASK 0x7ff
#endif
#define IN(k) ((((PH_MASK) >> (k)) & 1) && lo <= (k) && (k) < hi)
#define SEAM(k) do { if (IN(k) && IN((k) + 1)) xcd_barrier(bar); } while (0)

#ifndef REPEAT_MASK
#define REPEAT_MASK 0
#endif
#define NREP(k) ((((REPEAT_MASK) >> (k)) & 1) ? 2 : 1)
#define REPBAR(rep) do { if (rep) xcd_barrier(bar); } while (0)
    if (IN(0)) { _Pragma("unroll") for (int rep = 0; rep < NREP(0); ++rep) { REPBAR(rep); p0_prologue(F); } } SEAM(0);
    if (IN(1)) { _Pragma("unroll") for (int rep = 0; rep < NREP(1); ++rep) { REPBAR(rep); p1_norm_mod(F); } } SEAM(1);
    if (IN(2)) { _Pragma("unroll") for (int rep = 0; rep < NREP(2); ++rep) { REPBAR(rep);
        pg8::ProbPlain P{(const bf16_t*)(F.ws + WS_H), (const bf16_t*)(F.ws + WS_WIN)}; pg8::StaticOrder S; S.init(T, DIN, F.G, F.bid);
        pg8::EpiBf16 E{(bf16_t*)(F.ws + WS_PROJ), DIN};
        pg8::gemm_phase<pg8::EpiBf16, pg8::StaticOrder, pg8::ProbPlain>(F.lds, P, S, E);
    } } SEAM(2);
    if (IN(3)) { _Pragma("unroll") for (int rep = 0; rep < NREP(3); ++rep) { REPBAR(rep);
        for (int u = F.bid; u < 256; u += F.G) hgrn_local_unit(F, u);
        if ((REPEAT_MASK) & 2048) { xcd_barrier(bar); for (int u = F.bid; u < 256; u += F.G) hgrn_local_unit(F, u); }
        attn_units(F);
        if ((REPEAT_MASK) & 4096) { xcd_barrier(bar); attn_units(F); }
    } } SEAM(3);
    if (IN(4)) { _Pragma("unroll") for (int rep = 0; rep < NREP(4); ++rep) { REPBAR(rep); p4_scan(F); } } SEAM(4);
    if (IN(5)) { _Pragma("unroll") for (int rep = 0; rep < NREP(5); ++rep) { REPBAR(rep);
        for (int u = F.bid; u < 256; u += F.G) p5_fixup_unit(F, u);
        p5_attn_merge(F);
    } } SEAM(5);
    if (IN(6)) { _Pragma("unroll") for (int rep = 0; rep < NREP(6); ++rep) { REPBAR(rep);
        pg8::ProbPlain P{(const bf16_t*)(F.ws + WS_YCAT), (const bf16_t*)(F.ws + WS_WOUT)}; pg8::StaticOrder S; S.init(T, D, F.G, F.bid);
        pg8::EpiBf16 E{(bf16_t*)(F.ws + WS_Y), D};
        pg8::gemm_phase<pg8::EpiBf16, pg8::StaticOrder, pg8::ProbPlain>(F.lds, P, S, E);
    } } SEAM(6);
    if (IN(7)) { p7_rows(F); } SEAM(7);
    if (IN(8)) { _Pragma("unroll") for (int rep = 0; rep < NREP(8); ++rep) { REPBAR(rep);
        LAS int* cntl = (LAS int*)(F.lds + MISC_OFF); LAS int* tbase = cntl + 32; LAS int* sorted_e = cntl + 128;
        moe_tables(F, cntl, tbase, sorted_e);
        pg8::ProbGU<MOE_FP8 ? 1 : 2> P{(const void*)(F.ws + (MOE_FP8 ? WS_H8 : WS_H)), (const void*)(F.ws + WS_WGU), (const int*)(F.ws + WS_TOK)};
        pg8::MoeOrder S{cntl, tbase, sorted_e, 8, F.G, F.bid};
        pg8::EpiGU<MOE_FP8 != 0> E{(void*)(F.ws + WS_ACT), F.b_gu};
        pg8::gemm_phase<pg8::EpiGU<MOE_FP8 != 0>, pg8::MoeOrder, pg8::ProbGU<MOE_FP8 ? 1 : 2>>(F.lds, P, S, E);
    } } SEAM(8);
    if (IN(9)) { _Pragma("unroll") for (int rep = 0; rep < NREP(9); ++rep) { REPBAR(rep);
        LAS int* cntl = (LAS int*)(F.lds + MISC_OFF); LAS int* tbase = cntl + 32; LAS int* sorted_e = cntl + 128;
        moe_tables(F, cntl, tbase, sorted_e);
        pg8::ProbDown<MOE_FP8 ? 1 : 2> P{(const void*)(F.ws + WS_ACT), (const void*)(F.ws + WS_WDN)};
        pg8::MoeOrder S{cntl, tbase, sorted_e, 4, F.G, F.bid};
        pg8::EpiDown<MOE_FP8 != 0> E{(bf16_t*)(F.ws + WS_YPAIR), F.b_down, (const int*)(F.ws + WS_TOK)};
        pg8::gemm_phase<pg8::EpiDown<MOE_FP8 != 0>, pg8::MoeOrder, pg8::ProbDown<MOE_FP8 ? 1 : 2>>(F.lds, P, S, E);
    } } SEAM(9);
    if (IN(10)) { _Pragma("unroll") for (int rep = 0; rep < NREP(10); ++rep) { REPBAR(rep); p10_final(F); } }
#undef IN
#undef SEAM
}

extern "C" void kernel_launch(void* const* d_in, const int* in_sizes, int n_in, void* d_out, int out_size, void* d_ws, size_t ws_size, hipStream_t stream) {
    static int grid = 0;
    if (grid == 0) {
        if (n_in != 19 || out_size != T * D || ws_size < WS_END) { fprintf(stderr, "kernel_launch: unexpected problem (n_in %d, out %d, ws %zu)\n", n_in, out_size, ws_size); grid = -1; return; }
        int dev = 0, cus = 0, per_cu = 0;
        if (hipGetDevice(&dev) != hipSuccess || hipDeviceGetAttribute(&cus, hipDeviceAttributeMultiprocessorCount, dev) != hipSuccess) { grid = -1; return; }
        if (hipFuncSetAttribute((const void*)fwd, hipFuncAttributeMaxDynamicSharedMemorySize, LDS_BYTES) != hipSuccess) { fprintf(stderr, "kernel_launch: hipFuncSetAttribute failed\n"); grid = -1; return; }
        if (hipOccupancyMaxActiveBlocksPerMultiprocessor(&per_cu, (const void*)fwd, 512, LDS_BYTES) != hipSuccess || per_cu < 1) { fprintf(stderr, "kernel_launch: occupancy query reports %d\n", per_cu); }
        (void)hipGetLastError();
        grid = cus;
    }
    if (grid < 0) return;
    (void)hipMemsetAsync((char*)d_ws + WS_CTL, 0, CTL_ZERO_BYTES, stream);
    Args a{};
    for (int i = 0; i < 19; ++i) a.in[i] = (const float*)d_in[i];
    a.out = (float*)d_out; a.ws = (unsigned char*)d_ws;
#if MK_N_LAUNCHES == 1
    a.ph_lo = 0; a.ph_hi = NPHASE;
    hipLaunchKernelGGL(fwd, dim3(grid), dim3(512), LDS_BYTES, stream, a);
#else
    for (int li = 0; li < NPHASE; ++li) { a.ph_lo = li; a.ph_hi = li + 1; hipLaunchKernelGGL(fwd, dim3(grid), dim3(512), LDS_BYTES, stream, a); }
#endif
}
```

```cpp
#include <hip/hip_runtime.h>
#include <cstdio>
#include <cstdint>

#ifndef MK_N_LAUNCHES
#define MK_N_LAUNCHES 1
#endif

#ifndef MOE_FP8
#define MOE_FP8 1
#endif
#ifndef G1_FP8
#define G1_FP8 1
#endif
#define LAS __attribute__((address_space(3)))
#define GAS __attribute__((address_space(1)))
typedef unsigned short bf16_t;
typedef short bf16x8 __attribute__((ext_vector_type(8)));
typedef short s16x4 __attribute__((ext_vector_type(4)));
typedef short v4i16_t __attribute__((ext_vector_type(4)));
typedef float f32x2 __attribute__((ext_vector_type(2)));
typedef float f32x4 __attribute__((ext_vector_type(4)));
typedef float f32x16 __attribute__((ext_vector_type(16)));
typedef unsigned u32x2 __attribute__((ext_vector_type(2)));
typedef unsigned u32x4 __attribute__((ext_vector_type(4)));
typedef __bf16 bf16x2_t __attribute__((ext_vector_type(2)));
typedef int v8i32 __attribute__((ext_vector_type(8)));
typedef unsigned u32x8 __attribute__((ext_vector_type(8)));

constexpr int D = 1024, NB = 4, SEQ = 4096, T = NB * SEQ;
constexpr int DIN = 3584;
constexpr int C_QA = 0, C_KA = 512, C_VA = 1024, C_QR = 1536, C_FR = 2048, C_IR = 2560, C_GR = 3072;
constexpr int NE = 32;
constexpr float EPS = 1e-6f;
constexpr int NPHASE = 11;
constexpr int LIST_CAP = 16384;
constexpr int ACT_ROWS = T * 4 + NE * 256;

constexpr size_t MiB = 1u << 20;
constexpr size_t WS_CTL = 0, CTL_ZERO_BYTES = 1 * MiB;
constexpr size_t WS_MOD = 1 * MiB;
constexpr size_t WS_WIN = 2 * MiB;
constexpr size_t WS_WOUT = 10 * MiB;
constexpr size_t WS_WRT = 12 * MiB;
constexpr size_t WS_WGU = 16 * MiB;
constexpr size_t WS_WDN = 144 * MiB;
constexpr size_t WS_H = 208 * MiB;
constexpr size_t WS_PROJ = 240 * MiB;
constexpr size_t WS_YCAT = 352 * MiB;
constexpr size_t WS_H8 = 320 * MiB;
constexpr size_t WS_HLO = 240 * MiB;
constexpr size_t WS_ACT = 240 * MiB;
constexpr size_t WS_PARTO = 384 * MiB;
constexpr size_t WS_LSE = 432 * MiB;
constexpr size_t WS_OLOC = 434 * MiB;
constexpr size_t WS_QE = 450 * MiB;
constexpr size_t WS_SLOC = 466 * MiB;
constexpr size_t WS_DTOT = 482 * MiB;
constexpr size_t WS_SIN = 483 * MiB;
constexpr size_t WS_Y = 492 * MiB;
constexpr size_t WS_YPAIR = 384 * MiB;
constexpr size_t WS_X2 = 556 * MiB;
constexpr size_t WS_TOK = 620 * MiB;
constexpr size_t WS_END = 624 * MiB;
static_assert(WS_ACT + (size_t)ACT_ROWS * 2048 <= WS_PARTO, "act overlay");
static_assert(WS_YPAIR + (size_t)T * 4 * 2048 <= WS_X2, "ypair overlay");

constexpr int CW_TMO = 0;
constexpr int CW_BAR = 4096;
constexpr int CW_CNT = 8192;

constexpr int RING_BYTES = 131072;
constexpr int MISC_OFF = RING_BYTES;
constexpr int IDXBUF_OFF = RING_BYTES + 8192;
constexpr int BARW_OFF = RING_BYTES + 16384 - 16;
constexpr int LDS_BYTES = RING_BYTES + 16384;

constexpr float F8_SA = 32.f, F8_SACT = 4.f, F8_SW = 1024.f;
__device__ __forceinline__ unsigned pk4_fp8(float a, float b, float c, float d) {
    a = __builtin_amdgcn_fmed3f(a, -448.f, 448.f); b = __builtin_amdgcn_fmed3f(b, -448.f, 448.f); c = __builtin_amdgcn_fmed3f(c, -448.f, 448.f); d = __builtin_amdgcn_fmed3f(d, -448.f, 448.f);
    int v = 0; v = __builtin_amdgcn_cvt_pk_fp8_f32(a, b, v, false); v = __builtin_amdgcn_cvt_pk_fp8_f32(c, d, v, true); return (unsigned)v;
}
__device__ __forceinline__ float bf2f(unsigned v) { return __uint_as_float(v << 16); }
__device__ __forceinline__ float bflo(unsigned v) { return __uint_as_float(v << 16); }
__device__ __forceinline__ float bfhi(unsigned v) { return __uint_as_float(v & 0xffff0000u); }
__device__ __forceinline__ unsigned pk2(float lo, float hi) { f32x2 v = {lo, hi}; bf16x2_t b = __builtin_convertvector(v, bf16x2_t); return __builtin_bit_cast(unsigned, b); }
__device__ __forceinline__ float wave_sum(float v) {
#pragma unroll
    for (int o = 32; o >= 1; o >>= 1) v += __shfl_xor(v, o);
    return v;
}
__device__ __forceinline__ float rcpf_(float x) { return __builtin_amdgcn_rcpf(x); }
__device__ __forceinline__ float sigmoidf_(float x) { return __builtin_amdgcn_rcpf(1.f + __builtin_amdgcn_exp2f(-1.4426950408889634f * x)); }
__device__ __forceinline__ int crow(int r, int hi) { return (r & 3) + 8 * (r >> 2) + 4 * hi; }
__device__ __forceinline__ s16x4 tr_read(const LAS unsigned char* p) { return __builtin_bit_cast(s16x4, __builtin_amdgcn_ds_read_tr16_b64_v4i16((LAS v4i16_t*)p)); }
__device__ __forceinline__ bf16x8 cat8(s16x4 lo, s16x4 hi) { return (bf16x8){lo[0], lo[1], lo[2], lo[3], hi[0], hi[1], hi[2], hi[3]}; }
__device__ __forceinline__ bf16x8 pack_step(const f32x16& x, int s) {
    u32x4 p; p.x = pk2(x[8 * s], x[8 * s + 1]); p.y = pk2(x[8 * s + 2], x[8 * s + 3]); p.z = pk2(x[8 * s + 4], x[8 * s + 5]); p.w = pk2(x[8 * s + 6], x[8 * s + 7]);
    return __builtin_bit_cast(bf16x8, p);
}
#define MFMA32(a, b, c) __builtin_amdgcn_mfma_f32_32x32x16_bf16((a), (b), (c), 0, 0, 0)

#define XB_TMO      128
#define XB_XCNT(j)  (256  + 64 * (j))
#define XB_XSUB(j)  (1280 + 64 * (j))
#define XB_XGEN(j)  (2304 + 64 * (j))
#define XB_TOP      3328
#define XB_TOPGEN   3392
#define XCD_BAR_WORDS 3456
#define XB_SPIN_CAP (1u << 18)
__device__ __forceinline__ unsigned xb_ld(unsigned* p)              { return __hip_atomic_load(p, __ATOMIC_RELAXED, __HIP_MEMORY_SCOPE_AGENT); }
__device__ __forceinline__ unsigned xb_add(unsigned* p, unsigned v) { return __hip_atomic_fetch_add(p, v, __ATOMIC_RELAXED, __HIP_MEMORY_SCOPE_AGENT); }
__device__ __forceinline__ unsigned xb_xcc_id() { return (unsigned)__builtin_amdgcn_s_getreg((3 << 11) | 20) & 0xFu; }
#define XB_SPIN(cond, bar) do { unsigned _sp = 0; while (cond) { __builtin_amdgcn_s_sleep(1); \
    if ((++_sp & 255u) == 0u) { if (xb_ld(&(bar)[XB_TMO])) break; if (_sp > XB_SPIN_CAP) { atomicAdd(&(bar)[XB_TMO], 1u); break; } } } } while (0)
struct XcdBarrier { unsigned* bar; unsigned x; volatile LAS unsigned* st; };
__device__ __forceinline__ XcdBarrier xcd_barrier_post(unsigned* bar, volatile LAS unsigned* st) {
    XcdBarrier b; b.bar = bar; b.x = xb_xcc_id(); b.st = st;
    if (threadIdx.x == 0) (void)xb_add(&bar[XB_XCNT(b.x)], 1u);
    return b;
}
__device__ __forceinline__ void xcd_barrier_complete(unsigned* bar, unsigned x, unsigned& nloc, unsigned& nx) {
    const unsigned G = gridDim.x * gridDim.y * gridDim.z;
    unsigned sum, cnt, mine, sp = 0u;
    for (;;) {
        sum = 0u; cnt = 0u; mine = 0u;
#pragma unroll
        for (unsigned j = 0; j < 16; ++j) { const unsigned c = xb_ld(&bar[XB_XCNT(j)]); sum += c; cnt += (c > 0u) ? 1u : 0u; mine = (j == x) ? c : mine; }
        if (sum == G) break;
        __builtin_amdgcn_s_sleep(1);
        if ((++sp & 255u) == 0u) { if (xb_ld(&bar[XB_TMO])) break; if (sp > XB_SPIN_CAP) { atomicAdd(&bar[XB_TMO], 1u); break; } }
    }
    nloc = mine > 0u ? mine : 1u; nx = cnt > 0u ? cnt : 1u;
}
__device__ __forceinline__ void xcd_barrier(const XcdBarrier& b) {
    asm volatile("s_waitcnt vmcnt(0)" ::: "memory");
    __syncthreads();
    if (threadIdx.x == 0) {
        unsigned* bar = b.bar;
        __builtin_amdgcn_s_waitcnt(0);
        unsigned nloc = b.st[0], nx = b.st[1];
        if (nloc == 0u) { xcd_barrier_complete(bar, b.x, nloc, nx); b.st[0] = nloc; b.st[1] = nx; }
        const unsigned old = xb_add(&bar[XB_XSUB(b.x)], 1u);
        const unsigned gen = old / nloc;
        if (old + 1u == (gen + 1u) * nloc) {
            __builtin_amdgcn_fence(__ATOMIC_RELEASE, "agent");
            asm volatile("s_waitcnt vmcnt(0)" ::: "memory");
            const unsigned og = xb_add(&bar[XB_TOP], 1u);
            const unsigned tg = og / nx;
            if (og + 1u == (tg + 1u) * nx) xb_add(&bar[XB_TOPGEN], 1u);
            else XB_SPIN(xb_ld(&bar[XB_TOPGEN]) == tg, bar);
            __builtin_amdgcn_fence(__ATOMIC_ACQUIRE, "agent");
            xb_add(&bar[XB_XGEN(b.x)], 1u);
            asm volatile("s_waitcnt vmcnt(0)" ::: "memory");
        } else {
            XB_SPIN(xb_ld(&bar[XB_XGEN(b.x)]) == gen, bar);
            __builtin_amdgcn_fence(__ATOMIC_ACQUIRE, "agent");
            asm volatile("s_waitcnt vmcnt(0)" ::: "memory");
        }
    }
    __syncthreads();
}

namespace pg8 {
constexpr int BM = 256, BK = 64, HALF = 128, HTB = HALF * BK * 2, NXCD = 8, WGM = 8, KD = 1024;
__host__ __device__ __forceinline__ int lds_byte(int r, int c) { const int st = (r >> 4) * 2 + (c >> 5), rr = r & 15, cc = c & 31, ob = rr * 64 + cc * 2; return st * 1024 + (ob ^ (((ob >> 9) & 1) << 5)); }
__host__ __device__ __forceinline__ void stage_rc(int b, int& R, int& C) { const int st = b / 1024, sb = b % 1024, swz = sb ^ (((sb >> 9) & 1) << 5); R = (st >> 1) * 16 + swz / 64; C = (st & 1) * 32 + (swz % 64) / 2; }
__host__ __device__ __forceinline__ int perm32(int rho) { const int n = rho >> 4, i = rho & 15; return 8 * (i >> 2) + 4 * n + (i & 3); }

struct Unit { int pm, pn, e, rt, nvalid; };

struct StaticOrder {
    int nM, nN, nwg, G, c;
    __device__ void init(int M, int N, int G_, int c_) { nM = M / BM; nN = N / BM; nwg = nM * nN; G = G_; c = c_; }
    __device__ bool next(int i, Unit& u) const {
        const long L = (long)i * G + c; if (L >= nwg) return false;
        int wgid = (int)L; { const int q = nwg / NXCD, r = nwg % NXCD, xcd = wgid % NXCD, off = wgid / NXCD; wgid = (xcd < r ? xcd * (q + 1) : r * (q + 1) + (xcd - r) * q) + off; }
        const int nig = WGM * nN, gid = wgid / nig, fm = gid * WGM, gsz = (nM - fm) < WGM ? (nM - fm) : WGM;
        u.pm = fm + ((wgid % nig) % gsz); u.pn = (wgid % nig) / gsz; u.e = 0; u.rt = 0; u.nvalid = 256; return true;
    }
};
struct MoeOrder { static constexpr bool IS_MOE = true;
    const LAS int* cnt; const LAS int* tbase; const LAS int* tile_e; int ncol, G, c;
    __device__ bool next(int i, Unit& u) const {
        const int ng = (G % 8 == 0) ? 8 : 1, nl = G / ng, x = c % ng, j = c / ng, NT = tbase[NE];
        const int t0 = (x * NT) / ng, t1 = ((x + 1) * NT) / ng; const int pos = i * nl + j;
        if (pos >= (t1 - t0) * ncol) return false;
        const int gt = t0 + pos / ncol; const int e = tile_e[gt];
        u.e = __builtin_amdgcn_readfirstlane(e); u.rt = __builtin_amdgcn_readfirstlane(gt - tbase[e]); u.pn = __builtin_amdgcn_readfirstlane(pos % ncol);
        u.pm = __builtin_amdgcn_readfirstlane(gt); const int left = cnt[e] - u.rt * 256; u.nvalid = __builtin_amdgcn_readfirstlane(left < 256 ? left : 256); return true;
    }
};
template <int ELT_> struct ProbPlain {
    static constexpr bool GATHER = false, SWZ8 = false; static constexpr int ELT = ELT_;
    const void* A; const void* Bt;
    __device__ __forceinline__ const char* a_ptr(const Unit& u) const { return (const char*)A + (size_t)u.pm * (256 * KD * ELT); }
    __device__ __forceinline__ const char* b_ptr(const Unit& u) const { return (const char*)Bt + (size_t)u.pn * (256 * KD * ELT); }
    __device__ __forceinline__ const int* list_ptr(const Unit&) const { return nullptr; }
};
template <int ELT_> struct ProbGU {
    static constexpr bool GATHER = true, SWZ8 = true; static constexpr int ELT = ELT_;
    const void* A; const void* Bt; const int* list;
    __device__ __forceinline__ const char* a_ptr(const Unit&) const { return (const char*)A; }
    __device__ __forceinline__ const char* b_ptr(const Unit& u) const { return (const char*)Bt + ((size_t)u.e * 2048 + (size_t)u.pn * 256) * (KD * ELT); }
    __device__ __forceinline__ const int* list_ptr(const Unit& u) const { return list + 2 * ((size_t)u.e * LIST_CAP + u.rt * 256); }
};
template <int ELT_> struct ProbDown {
    static constexpr bool GATHER = false, SWZ8 = false; static constexpr int ELT = ELT_;
    const void* A; const void* Bt;
    __device__ __forceinline__ const char* a_ptr(const Unit& u) const { return (const char*)A + (size_t)u.pm * (256 * KD * ELT); }
    __device__ __forceinline__ const char* b_ptr(const Unit& u) const { return (const char*)Bt + ((size_t)u.e * 1024 + (size_t)u.pn * 256) * (KD * ELT); }
    __device__ __forceinline__ const int* list_ptr(const Unit&) const { return nullptr; }
};

struct EpiBf16 {
    static constexpr bool PERM = true;
    bf16_t* O; int ldc; float sc;
    __device__ __forceinline__ void operator()(const f32x4 (&acc)[2][2][4][2], const Unit& u, int wr, int wc, int fr, int fq) const {
        const int row0 = u.pm * BM + wr * 64 + fr, col0 = u.pn * BM + wc * 32 + 8 * fq;
#pragma unroll
        for (int ai = 0; ai < 2; ++ai)
#pragma unroll
            for (int m = 0; m < 4; ++m) { bf16_t* rowp = O + (size_t)(row0 + ai * HALF + m * 16) * ldc + col0;
#pragma unroll
                for (int bj = 0; bj < 2; ++bj) { const f32x4 v0 = acc[ai][bj][m][0] * sc, v1 = acc[ai][bj][m][1] * sc;
                    u32x4 w; w.x = pk2(v0[0], v0[1]); w.y = pk2(v0[2], v0[3]); w.z = pk2(v1[0], v1[1]); w.w = pk2(v1[2], v1[3]);
                    *(u32x4*)(rowp + bj * HALF) = w; } }
    }
};
struct EpiF32 {
    static constexpr bool PERM = false;
    float* C; int ldc;
    __device__ __forceinline__ void operator()(const f32x4 (&acc)[2][2][4][2], const Unit& u, int wr, int wc, int fr, int fq) const {
        const int row0 = u.pm * BM + wr * 64 + fr, col0 = u.pn * BM + wc * 32 + 4 * fq;
#pragma unroll
        for (int ai = 0; ai < 2; ++ai)
#pragma unroll
            for (int m = 0; m < 4; ++m) { float* rowp = C + (size_t)(row0 + ai * HALF + m * 16) * ldc + col0;
#pragma unroll
                for (int bj = 0; bj < 2; ++bj)
#pragma unroll
                    for (int n = 0; n < 2; ++n) *(f32x4*)(rowp + bj * HALF + n * 16) = acc[ai][bj][m][n]; }
    }
};
template <bool F8> struct EpiGU {
    static constexpr bool PERM = true;
    void* act; const float* b_gu;
    __device__ __forceinline__ void operator()(const f32x4 (&acc)[2][2][4][2], const Unit& u, int wr, int wc, int fr, int fq) const {
        const int row0 = u.pm * BM + wr * 64 + fr, col0 = u.pn * 128 + wc * 32 + 8 * fq;
        const float* bg = b_gu + (size_t)u.e * 2048 + col0;
        const f32x4 bg0 = *(const f32x4*)(bg), bg1 = *(const f32x4*)(bg + 4), bl0 = *(const f32x4*)(bg + 1024), bl1 = *(const f32x4*)(bg + 1028);
        __builtin_amdgcn_s_waitcnt(0x0F70);
        const float sc = F8 ? 1.f / (F8_SA * F8_SW) : 1.f;
#pragma unroll
        for (int ai = 0; ai < 2; ++ai)
#pragma unroll
            for (int m = 0; m < 4; ++m) {
                float r[8];
#pragma unroll
                for (int n = 0; n < 2; ++n)
#pragma unroll
                    for (int j = 0; j < 4; ++j) {
                        float g = acc[ai][0][m][n][j] * sc + (n ? bg1[j] : bg0[j]); float l = acc[ai][1][m][n][j] * sc + (n ? bl1[j] : bl0[j]);
                        g = fminf(g, 7.0f); l = __builtin_amdgcn_fmed3f(l, -7.0f, 7.0f);
                        r[n * 4 + j] = g * __builtin_amdgcn_rcpf(1.f + __builtin_amdgcn_exp2f(-1.702f * 1.4426950408889634f * g)) * (l + 1.0f); }
                if (F8) { u32x2 w; w.x = pk4_fp8(r[0] * F8_SACT, r[1] * F8_SACT, r[2] * F8_SACT, r[3] * F8_SACT); w.y = pk4_fp8(r[4] * F8_SACT, r[5] * F8_SACT, r[6] * F8_SACT, r[7] * F8_SACT);
                    *(u32x2*)((unsigned char*)act + (size_t)(row0 + ai * HALF + m * 16) * 1024 + col0) = w; }
                else { u32x4 w; w.x = pk2(r[0], r[1]); w.y = pk2(r[2], r[3]); w.z = pk2(r[4], r[5]); w.w = pk2(r[6], r[7]);
                    *(u32x4*)((bf16_t*)act + (size_t)(row0 + ai * HALF + m * 16) * 1024 + col0) = w; } }
    }
};
template <bool F8> struct EpiDown {
    static constexpr bool PERM = true;
    bf16_t* ypair; const float* b_down; const int* list;
    __device__ __forceinline__ void operator()(const f32x4 (&acc)[2][2][4][2], const Unit& u, int wr, int wc, int fr, int fq) const {
        const int col0 = u.pn * BM + wc * 32 + 8 * fq;
        const float* bd = b_down + (size_t)u.e * 1024 + col0;
        f32x4 bv[2][2];
#pragma unroll
        for (int bj = 0; bj < 2; ++bj)
#pragma unroll
            for (int n = 0; n < 2; ++n) bv[bj][n] = *(const f32x4*)(bd + bj * HALF + 4 * n);
        const u32x2* lp = (const u32x2*)list + (size_t)u.e * LIST_CAP + u.rt * 256;
        int pr[2][4]; float gt[2][4];
#pragma unroll
        for (int ai = 0; ai < 2; ++ai)
#pragma unroll
            for (int m = 0; m < 4; ++m) { const int r = ai * HALF + wr * 64 + m * 16 + fr; const bool ok = r < u.nvalid; const u32x2 en = lp[ok ? r : 0]; pr[ai][m] = ok ? (int)en.x : -1; gt[ai][m] = __uint_as_float(en.y); }
        __builtin_amdgcn_s_waitcnt(0x0F70);
#pragma unroll
        for (int ai = 0; ai < 2; ++ai)
#pragma unroll
            for (int m = 0; m < 4; ++m) {
                if (pr[ai][m] >= 0) {
                    bf16_t* rowp = ypair + (size_t)pr[ai][m] * 1024 + col0; const float g = gt[ai][m]; const float sc = F8 ? 1.f / (F8_SACT * F8_SW) : 1.f;
#pragma unroll
                    for (int bj = 0; bj < 2; ++bj) { const f32x4 v0 = (acc[ai][bj][m][0] * sc + bv[bj][0]) * g, v1 = (acc[ai][bj][m][1] * sc + bv[bj][1]) * g;
                        u32x4 w; w.x = pk2(v0[0], v0[1]); w.y = pk2(v0[2], v0[3]); w.z = pk2(v1[0], v1[1]); w.w = pk2(v1[2], v1[3]);
                        *(u32x4*)(rowp + bj * HALF) = w; }
                }
            }
    }
};

template <class Epi, class Sched, class Prob>
__device__ __forceinline__ void gemm_phase(LAS unsigned char* lds, const Prob& P, const Sched& S, const Epi& E) {
    const int tid = threadIdx.x, wid = __builtin_amdgcn_readfirstlane(tid >> 6), lane = tid & 63, wr = wid >> 2, wc = wid & 3, fr = lane & 15, fq = lane >> 4;
    constexpr int ELT = Prob::ELT, K = KD * ELT / 2  , nt = (KD * ELT) / (BK * 2);
    unsigned voffA, voffB;
#define PG8_MKOFF(T) do { int R, C; stage_rc((T) * 16, R, C); const int Rb = Epi::PERM ? ((R & ~31) + perm32(R & 31)) : R; voffA = (unsigned)(R * K + C) * 2u; voffB = (unsigned)(Rb * K + C) * 2u; } while (0)
    PG8_MKOFF(tid);
    constexpr unsigned istep = 64u * (unsigned)K * 2u;
    unsigned voffG[2][2] = {{0u, 0u}, {0u, 0u}};
    LAS int* idxbuf = (LAS int*)(lds + IDXBUF_OFF);
    const size_t kstep = (size_t)(BK * 2);
    const size_t hstep = (size_t)HALF * K * 2;
    const unsigned ldsw = (unsigned)wid * 1024u;
    const int sw8 = Prob::SWZ8 ? 16 * (fq & 1) : 0;
    const int aoff = lds_byte(wr * 64 + fr, fq * 8 * (3 - ELT)), boff = lds_byte(wc * 32 + fr, fq * 8 * (3 - ELT));
#define PG8_SA(b, h) (((b) * 2 + (h)) * HTB)
#define PG8_SB(b, h) ((4 + (b) * 2 + (h)) * HTB)
#define PG8_STAGE(bufoff, gbase, voff) do { _Pragma("unroll") for (int _i = 0; _i < 2; ++_i) \
        __builtin_amdgcn_global_load_lds((const unsigned*)((const char*)(gbase) + _i * istep + (voff)), (LAS unsigned*)(lds + (bufoff) + ldsw + _i * 8192), 16, 0, 0); } while (0)
#define PG8_GSTAGE(bufoff, gbase, voff) do { _Pragma("unroll") for (int _i = 0; _i < 2; ++_i) \
        __builtin_amdgcn_global_load_lds((const unsigned*)((const char*)(gbase) + (voff)[_i]), (LAS unsigned*)(lds + (bufoff) + ldsw + _i * 8192), 16, 0, 0); } while (0)
#define PG8_ASTAGE(bufoff, gbase, h) do { if constexpr (Prob::GATHER) { PG8_GSTAGE(bufoff, gbase, voffG[h]); } else { PG8_STAGE(bufoff, (gbase) + (h) * hstep, voffA); } } while (0)
#define PG8_LD8(addr) __builtin_shufflevector(*(const LAS u32x4*)((addr) + sw8), *(const LAS u32x4*)((addr) + 16 - sw8), 0, 1, 2, 3, 4, 5, 6, 7)
#define PG8_LDA(dst, b, h) do { if constexpr (ELT == 2) { _Pragma("unroll") for (int m = 0; m < 4; ++m) _Pragma("unroll") for (int k = 0; k < 2; ++k) dst[m][k] = *(const LAS u32x4*)(lds + PG8_SA(b, h) + aoff + m * 2048 + k * 1024); } \
        else { _Pragma("unroll") for (int m = 0; m < 4; ++m) dst##8[m] = PG8_LD8(lds + PG8_SA(b, h) + aoff + m * 2048); } } while (0)
#define PG8_LDB(dst, b, h) do { if constexpr (ELT == 2) { _Pragma("unroll") for (int n = 0; n < 2; ++n) _Pragma("unroll") for (int k = 0; k < 2; ++k) dst[n][k] = *(const LAS u32x4*)(lds + PG8_SB(b, h) + boff + n * 2048 + k * 1024); } \
        else { _Pragma("unroll") for (int n = 0; n < 2; ++n) dst##8[n] = PG8_LD8(lds + PG8_SB(b, h) + boff + n * 2048); } } while (0)
#define PG8_MMA(ai, bj, At, Bt) do { __builtin_amdgcn_s_setprio(1); if constexpr (ELT == 2) { _Pragma("unroll") for (int m = 0; m < 4; ++m) _Pragma("unroll") for (int n = 0; n < 2; ++n) _Pragma("unroll") for (int k = 0; k < 2; ++k) \
        acc[ai][bj][m][n] = __builtin_amdgcn_mfma_f32_16x16x32_bf16(__builtin_bit_cast(bf16x8, Bt[n][k]), __builtin_bit_cast(bf16x8, At[m][k]), acc[ai][bj][m][n], 0, 0, 0); } \
        else { _Pragma("unroll") for (int m = 0; m < 4; ++m) _Pragma("unroll") for (int n = 0; n < 2; ++n) \
        acc[ai][bj][m][n] = __builtin_amdgcn_mfma_scale_f32_16x16x128_f8f6f4(__builtin_bit_cast(v8i32, Bt##8[n]), __builtin_bit_cast(v8i32, At##8[m]), acc[ai][bj][m][n], 0, 0, 0, 0x7F7F7F7F, 0, 0x7F7F7F7F); } \
        __builtin_amdgcn_s_setprio(0); } while (0)
#define PG8_WAIT_V(n) asm volatile("s_waitcnt vmcnt(" #n ")" ::: "memory")
#define PG8_WAIT_L(n) asm volatile("s_waitcnt lgkmcnt(" #n ")" ::: "memory")
#define PG8_BAR __builtin_amdgcn_s_barrier()
#define PG8_SCHED __builtin_amdgcn_sched_barrier(0)
    Unit cur, nxt; int ui = 0;
    if (!S.next(0, cur)) return;
    f32x4 acc[2][2][4][2];
#pragma unroll
    for (int a = 0; a < 2; ++a)
#pragma unroll
        for (int b = 0; b < 2; ++b)
#pragma unroll
            for (int m = 0; m < 4; ++m)
#pragma unroll
                for (int n = 0; n < 2; ++n) acc[a][b][m][n] = (f32x4){0.f, 0.f, 0.f, 0.f};
    u32x4 At[4][2], B0[2][2], B1[2][2];
    u32x8 At8[4], B08[2], B18[2];
    const char* cA = P.a_ptr(cur); const char* cB = P.b_ptr(cur);
    if constexpr (Prob::GATHER) {
        const int* lp = P.list_ptr(cur); const int R0 = (wid >> 1) * 16 + (lane >> 2); const unsigned coff = (unsigned)((wid & 1) * 32 + (((lane & 3) * 8) ^ ((lane >> 5) << 4))) * 2u;
#pragma unroll
        for (int h = 0; h < 2; ++h)
#pragma unroll
            for (int i = 0; i < 2; ++i) { const int row = h * 128 + R0 + 64 * i; const int pair = (row < cur.nvalid) ? lp[2 * row] : 0; voffG[h][i] = (unsigned)(pair >> 2) * (unsigned)(KD * ELT) + coff; }
        Unit u1; if (S.next(1, u1) && tid < 256) idxbuf[256 + tid] = P.list_ptr(u1)[2 * tid];
    }
    PG8_STAGE(PG8_SB(0, 0), cB, voffB); PG8_STAGE(PG8_SB(0, 1), cB + hstep, voffB); PG8_ASTAGE(PG8_SA(0, 0), cA, 0); PG8_ASTAGE(PG8_SA(0, 1), cA, 1);
    if (wr == 1) PG8_BAR;
    PG8_WAIT_V(2); PG8_BAR;
    PG8_STAGE(PG8_SB(1, 0), cB + kstep, voffB); PG8_ASTAGE(PG8_SA(1, 0), cA + kstep, 0); PG8_STAGE(PG8_SB(1, 1), cB + hstep + kstep, voffB);
    PG8_WAIT_V(6); PG8_BAR;
    for (;;) {
        const bool has_next = S.next(ui + 1, nxt);
        const char* nA = has_next ? P.a_ptr(nxt) : cA; const char* nB = has_next ? P.b_ptr(nxt) : cB;
#pragma unroll 1
        for (int t = 0; t < nt; t += 2) {
            const bool last = (t == nt - 2);
            const char* a1 = cA + (size_t)(t + 1) * kstep;
            const char* a2 = last ? nA : cA + (size_t)(t + 2) * kstep; const char* b2 = last ? nB : cB + (size_t)(t + 2) * kstep;
            const char* a3 = a2 + kstep; const char* b3 = b2 + kstep;
            { int tz = threadIdx.x; asm volatile("" : "+v"(tz)); PG8_MKOFF(tz); }
            PG8_LDB(B0, 0, 0); PG8_LDB(B1, 0, 1); PG8_SCHED; PG8_LDA(At, 0, 0); PG8_ASTAGE(PG8_SA(1, 1), a1, 1);
            if constexpr (Prob::GATHER) { if (last && has_next) {
                const int R0 = (wid >> 1) * 16 + (lane >> 2); const unsigned coff = (unsigned)((wid & 1) * 32 + (((lane & 3) * 8) ^ ((lane >> 5) << 4))) * 2u; const LAS int* ib = idxbuf + ((ui + 1) & 1) * 256;
#pragma unroll
                for (int h = 0; h < 2; ++h)
#pragma unroll
                    for (int i = 0; i < 2; ++i) { const int row = h * 128 + R0 + 64 * i; const int pair = (row < nxt.nvalid) ? ib[row] : 0; voffG[h][i] = (unsigned)(pair >> 2) * (unsigned)(KD * ELT) + coff; } } }
            PG8_WAIT_V(8); PG8_WAIT_L(0); PG8_BAR; PG8_MMA(0, 0, At, B0); PG8_MMA(0, 1, At, B1); PG8_BAR; PG8_SCHED;
            PG8_LDA(At, 0, 1); PG8_STAGE(PG8_SB(0, 0), b2, voffB); PG8_STAGE(PG8_SB(0, 1), b2 + hstep, voffB); PG8_ASTAGE(PG8_SA(0, 0), a2, 0);
            PG8_WAIT_V(8); PG8_WAIT_L(0); PG8_BAR; PG8_MMA(1, 0, At, B0); PG8_MMA(1, 1, At, B1); PG8_BAR; PG8_SCHED;
            PG8_LDB(B0, 1, 0); PG8_LDB(B1, 1, 1); PG8_SCHED; PG8_LDA(At, 1, 0); PG8_ASTAGE(PG8_SA(0, 1), a2, 1);
            PG8_WAIT_V(8); PG8_WAIT_L(0); PG8_BAR; PG8_MMA(0, 0, At, B0); PG8_MMA(0, 1, At, B1); PG8_BAR; PG8_SCHED;
            PG8_LDA(At, 1, 1); PG8_STAGE(PG8_SB(1, 0), b3, voffB); PG8_STAGE(PG8_SB(1, 1), b3 + hstep, voffB); PG8_ASTAGE(PG8_SA(1, 0), a3, 0);
            PG8_WAIT_V(8); PG8_WAIT_L(0); PG8_BAR; PG8_MMA(1, 0, At, B0); PG8_MMA(1, 1, At, B1); PG8_BAR; PG8_SCHED;
        }
        if (wr == 0) PG8_BAR;
        int nidx = 0; bool have2 = false;
        if constexpr (Prob::GATHER) { Unit u2; have2 = S.next(ui + 2, u2); if (have2 && tid < 256) nidx = P.list_ptr(u2)[2 * tid]; }
        { int tz = threadIdx.x; asm volatile("" : "+v"(tz));
          const int wz = tz >> 6, lz = tz & 63; E(acc, cur, wz >> 2, wz & 3, lz & 15, lz >> 4); }
        if constexpr (Prob::GATHER) { if (have2 && tid < 256) idxbuf[(ui & 1) * 256 + tid] = nidx; }
        if (!has_next) break;
#pragma unroll
        for (int a = 0; a < 2; ++a)
#pragma unroll
            for (int b = 0; b < 2; ++b)
#pragma unroll
                for (int m = 0; m < 4; ++m)
#pragma unroll
                    for (int n = 0; n < 2; ++n) acc[a][b][m][n] = (f32x4){0.f, 0.f, 0.f, 0.f};
        cur = nxt; cA = nA; cB = nB; ++ui;
        if (wr == 1) PG8_BAR;
    }
    PG8_WAIT_V(0);
    PG8_BAR;
#undef PG8_SA
#undef PG8_SB
#undef PG8_STAGE
#undef PG8_GSTAGE
#undef PG8_MKOFF
#undef PG8_ASTAGE
#undef PG8_LDA
#undef PG8_LDB
#undef PG8_MMA
#undef PG8_WAIT_V
#undef PG8_WAIT_L
#undef PG8_BAR
#undef PG8_SCHED
}
}

struct Args { const float* in[19]; float* out; unsigned char* ws; int ph_lo, ph_hi; };
typedef const Args __attribute__((address_space(4)))* CArgs;
struct Ctx {
    LAS unsigned char* lds; int tid, lane, wave, G, bid; CArgs ap; unsigned char* ws;
};
#define LDS_FENCE() asm volatile("s_waitcnt lgkmcnt(0)" ::: "memory")

template <bool F8> __device__ __forceinline__ void p0_transpose_item(const float* W, int N, int k0, int n0, void* dst_row0, LAS float* scr, int lane) {
    const int q = lane & 15, kr = lane >> 4;
    f32x4 v[16];
#pragma unroll
    for (int i = 0; i < 16; ++i) v[i] = *(const f32x4*)(W + (size_t)(k0 + 4 * i + kr) * N + n0 + 4 * q);
#pragma unroll
    for (int i = 0; i < 16; ++i) { const int k = 4 * i + kr;
        scr[(4 * q + 0) * 65 + k] = v[i].x; scr[(4 * q + 1) * 65 + k] = v[i].y; scr[(4 * q + 2) * 65 + k] = v[i].z; scr[(4 * q + 3) * 65 + k] = v[i].w; }
    LDS_FENCE();
    if (F8) { const int c = lane & 3;
#pragma unroll
        for (int j = 0; j < 4; ++j) { const int n = (lane >> 2) + 16 * j; const LAS float* s = scr + n * 65 + 16 * c;
            u32x4 o; o.x = pk4_fp8(s[0] * F8_SW, s[1] * F8_SW, s[2] * F8_SW, s[3] * F8_SW); o.y = pk4_fp8(s[4] * F8_SW, s[5] * F8_SW, s[6] * F8_SW, s[7] * F8_SW);
            o.z = pk4_fp8(s[8] * F8_SW, s[9] * F8_SW, s[10] * F8_SW, s[11] * F8_SW); o.w = pk4_fp8(s[12] * F8_SW, s[13] * F8_SW, s[14] * F8_SW, s[15] * F8_SW);
            *(u32x4*)((unsigned char*)dst_row0 + (size_t)n * 1024 + k0 + 16 * c) = o; }
    } else { const int c = lane & 7;
#pragma unroll
        for (int j = 0; j < 8; ++j) { const int n = (lane >> 3) + 8 * j; const LAS float* s = scr + n * 65 + 8 * c;
            u32x4 o; o.x = pk2(s[0], s[1]); o.y = pk2(s[2], s[3]); o.z = pk2(s[4], s[5]); o.w = pk2(s[6], s[7]);
            *(u32x4*)((bf16_t*)dst_row0 + (size_t)n * 1024 + k0 + 8 * c) = o; }
    }
    LDS_FENCE();
}
__device__ __forceinline__ void p0_prologue(Ctx& F) {
    {
        LAS float* cond = (LAS float*)F.lds; LAS float* red = cond + 4096;
        for (int i = F.tid; i < 4096; i += 512) { const float v = (F.ap->in[1])[i]; cond[i] = v * sigmoidf_(v); }
        __syncthreads();
        float* mod = (float*)(F.ws + WS_MOD);
        for (int u = F.bid; u < 192; u += F.G) {
            const int n0 = u * 32, q = F.tid & 7, kg = F.tid >> 3;
            f32x4 a0 = {0.f, 0.f, 0.f, 0.f}, a1 = a0, a2 = a0, a3 = a0;
#pragma unroll 4
            for (int i = 0; i < 16; ++i) { const int k = kg + 64 * i; const f32x4 w = *(const f32x4*)((F.ap->in[2]) + (size_t)k * 6144 + n0 + 4 * q);
                a0 += w * cond[k]; a1 += w * cond[1024 + k]; a2 += w * cond[2048 + k]; a3 += w * cond[3072 + k]; }
            *(LAS f32x4*)(red + kg * 128 + 0 + 4 * q) = a0; *(LAS f32x4*)(red + kg * 128 + 32 + 4 * q) = a1;
            *(LAS f32x4*)(red + kg * 128 + 64 + 4 * q) = a2; *(LAS f32x4*)(red + kg * 128 + 96 + 4 * q) = a3;
            __syncthreads();
            if (F.tid < 128) { float s = 0.f;
                for (int g = 0; g < 64; ++g) s += red[g * 128 + F.tid];
                const int b = F.tid >> 5, col = F.tid & 31; mod[b * 6144 + n0 + col] = s + (F.ap->in[3])[n0 + col]; }
            __syncthreads();
        }
        __syncthreads();
    }
    for (int idx = F.bid * 512 + F.tid; idx < 32768; idx += F.G * 512) { const int k = idx >> 5, e = idx & 31; const float w = (F.ap->in[13])[idx];
        const unsigned hi = pk2(w, 0.f) & 0xffffu; const unsigned lo = pk2(w - bf2f(hi), 0.f) & 0xffffu;
        bf16_t* wrt = (bf16_t*)(F.ws + WS_WRT); wrt[e * 1024 + k] = (bf16_t)hi; wrt[32768 + e * 1024 + k] = (bf16_t)lo; }
    LAS float* scr = (LAS float*)F.lds + F.wave * 4160;
    const int gw = F.bid * 8 + F.wave, NGW = F.G * 8;
    constexpr int I_GU = 32 * 16 * 32, I_DN = 32 * 16 * 16, I_IN = 16 * 56, I_OUT = 16 * 16, NITEMS = I_IN + I_OUT + I_GU + I_DN;
    for (int it = gw; it < NITEMS; it += NGW) {
        int r = it;
        if (r < I_GU) { const int e = r / 512, r2 = r % 512, kb = r2 / 32, nb = r2 % 32; const int n0 = nb * 64;
            const int drow = (n0 < 1024) ? ((n0 >> 7) * 256 + (n0 & 127)) : (((n0 - 1024) >> 7) * 256 + 128 + ((n0 - 1024) & 127));
            p0_transpose_item<MOE_FP8 != 0>((F.ap->in[15]) + (size_t)e * 1024 * 2048, 2048, kb * 64, n0, (unsigned char*)(F.ws + WS_WGU) + ((size_t)e * 2048 + drow) * (MOE_FP8 ? 1024 : 2048), scr, F.lane);
            continue; } r -= I_GU;
        if (r < I_DN) { const int e = r / 256, r2 = r % 256, kb = r2 / 16, nb = r2 % 16;
            p0_transpose_item<MOE_FP8 != 0>((F.ap->in[17]) + (size_t)e * 1024 * 1024, 1024, kb * 64, nb * 64, (unsigned char*)(F.ws + WS_WDN) + ((size_t)e * 1024 + nb * 64) * (MOE_FP8 ? 1024 : 2048), scr, F.lane);
            continue; } r -= I_DN;
        if (r < I_IN) { const int kb = r / 56, nb = r % 56; p0_transpose_item<G1_FP8 != 0>((F.ap->in[6]), DIN, kb * 64, nb * 64, (unsigned char*)(F.ws + WS_WIN) + (size_t)(nb * 64) * (G1_FP8 ? 1024 : 2048), scr, F.lane); continue; } r -= I_IN;
        { const int kb = r / 16, nb = r % 16; p0_transpose_item<false>((F.ap->in[10]), D, kb * 64, nb * 64, (bf16_t*)(F.ws + WS_WOUT) + (size_t)(nb * 64) * 1024, scr, F.lane); }
    }
}

__device__ __forceinline__ void p1_norm_mod(Ctx& F) {
    const int gw = F.bid * 8 + F.wave, NGW = F.G * 8;
    const float* mod = (const float*)(F.ws + WS_MOD);
    bf16_t* H = (bf16_t*)(F.ws + WS_H);
    f32x4 nv[4];
    if (gw < T) {
#pragma unroll
        for (int j = 0; j < 4; ++j) nv[j] = ((const f32x4*)((F.ap->in[0]) + (size_t)gw * D) + F.lane)[64 * j]; }
    for (int m = gw; m < T; m += NGW) {
        const int b = m / SEQ;
        f32x4 v[4]; float ss = 0.f;
#pragma unroll
        for (int j = 0; j < 4; ++j) { v[j] = nv[j]; ss += (v[j].x * v[j].x + v[j].y * v[j].y) + (v[j].z * v[j].z + v[j].w * v[j].w); }
        if (m + NGW < T) {
#pragma unroll
            for (int j = 0; j < 4; ++j) nv[j] = ((const f32x4*)((F.ap->in[0]) + (size_t)(m + NGW) * D) + F.lane)[64 * j]; }
        const float rstd = 1.0f / sqrtf(wave_sum(ss) * (1.f / D) + EPS);
        u32x2* o = (u32x2*)(H + (size_t)m * D) + F.lane;
#pragma unroll
        for (int j = 0; j < 4; ++j) { const int k = 4 * F.lane + 256 * j;
            const f32x4 g = *(const f32x4*)((F.ap->in[4]) + k), sh = *(const f32x4*)(mod + b * 6144 + k), sc = *(const f32x4*)(mod + b * 6144 + 1024 + k);
            const f32x4 h = v[j] * rstd * g * (sc + 1.0f) + sh;
            if (G1_FP8) ((unsigned*)((unsigned char*)(F.ws + WS_H) + (size_t)m * D) + F.lane)[64 * j] = pk4_fp8(h.x * F8_SA, h.y * F8_SA, h.z * F8_SA, h.w * F8_SA);
            else { u32x2 w; w.x = pk2(h.x, h.y); w.y = pk2(h.z, h.w); o[64 * j] = w; } }
    }
}

constexpr int HG_QE = 0, HG_KE = 8704, HG_KD = 17408, HG_V = 27648, HG_SEG = 37888, HG_DEC = 41984, HG_OP = 42496;
__device__ __forceinline__ void hgrn_local_unit(Ctx& F, int u) {
    const int bh = u >> 4, jj = u & 15, b = bh >> 2, h = bh & 3;
    const int rowbase = b * SEQ + jj * 256;
    const bf16_t* proj = (const bf16_t*)(F.ws + WS_PROJ);
    bf16_t* QE = (bf16_t*)(F.ws + WS_QE); bf16_t* OLOC = (bf16_t*)(F.ws + WS_OLOC);
    LAS unsigned char* L = F.lds;
    const int seg = F.wave, dp = F.lane;
    const int eb = F.wave & 3, dh = F.wave >> 2, c32 = F.lane & 31, hh = F.lane >> 5;
    const int i16 = F.lane & 15, tq = i16 >> 2, tp = i16 & 3, blk = (F.lane >> 4) & 1;
    float lbv[2], oml[2], ecum[2] = {1.f, 1.f};
#pragma unroll
    for (int dd = 0; dd < 2; ++dd) { const int d = h * 128 + 2 * dp + dd; const float a0 = (F.ap->in[8])[d], a1 = (F.ap->in[8])[512 + d]; lbv[dd] = 1.f / (1.f + __expf(a1 - a0)); oml[dd] = 1.f - lbv[dd]; }
    f32x16 Sacc[2];
#pragma unroll
    for (int i = 0; i < 2; ++i)
#pragma unroll
        for (int r = 0; r < 16; ++r) Sacc[i][r] = 0.f;
    LAS float* segtot = (LAS float*)(L + HG_SEG); LAS float* dec = (LAS float*)(L + HG_DEC); LAS float* op = (LAS float*)(L + HG_OP);
    unsigned nfr[4], nqr[4], nv2[4];
#pragma unroll
    for (int i = 0; i < 4; ++i) { const bf16_t* rp = proj + (size_t)(rowbase + 4 * seg + i) * DIN + h * 128 + 2 * dp;
        nfr[i] = *(const unsigned*)(rp + C_FR); nqr[i] = *(const unsigned*)(rp + C_QR); nv2[i] = *(const unsigned*)(rp + C_IR); }
    for (int sc = 0; sc < 8; ++sc) {
        const int row0 = rowbase + sc * 32;
        unsigned fr2[4], qr2[4], v2[4];
#pragma unroll
        for (int i = 0; i < 4; ++i) { fr2[i] = nfr[i]; qr2[i] = nqr[i]; v2[i] = nv2[i]; }
        if (sc < 7) {
#pragma unroll
            for (int i = 0; i < 4; ++i) { const bf16_t* rp = proj + (size_t)(row0 + 32 + 4 * seg + i) * DIN + h * 128 + 2 * dp;
                nfr[i] = *(const unsigned*)(rp + C_FR); nqr[i] = *(const unsigned*)(rp + C_QR); nv2[i] = *(const unsigned*)(rp + C_IR); } }
        float Pc[4][2], kk[4][2], qq[4][2], run[2] = {1.f, 1.f};
#pragma unroll
        for (int i = 0; i < 4; ++i)
#pragma unroll
            for (int dd = 0; dd < 2; ++dd) {
                const float fr = dd ? bfhi(fr2[i]) : bflo(fr2[i]); const float qr = dd ? bfhi(qr2[i]) : bflo(qr2[i]);
                const float sg = sigmoidf_(fr); const float f = lbv[dd] + oml[dd] * sg;
                kk[i][dd] = oml[dd] * (1.f - sg); run[dd] *= f; Pc[i][dd] = run[dd]; qq[i][dd] = qr * sigmoidf_(qr); }
        *(LAS f32x2*)(segtot + seg * 128 + 2 * dp) = (f32x2){run[0], run[1]};
        __syncthreads();
        float pre[2] = {1.f, 1.f}, tot[2] = {1.f, 1.f};
#pragma unroll
        for (int s = 0; s < 8; ++s) { const f32x2 t2 = *(const LAS f32x2*)(segtot + s * 128 + 2 * dp);
            pre[0] *= (s < seg) ? t2.x : 1.f; pre[1] *= (s < seg) ? t2.y : 1.f; tot[0] *= t2.x; tot[1] *= t2.y; }
#pragma unroll
        for (int i = 0; i < 4; ++i) { const int trow = 4 * seg + i; float qe[2], ke[2], kd[2];
#pragma unroll
            for (int dd = 0; dd < 2; ++dd) { const float Eb = pre[dd] * Pc[i][dd]; const float inv = 1.f / Eb; qe[dd] = qq[i][dd] * Eb; ke[dd] = kk[i][dd] * inv; kd[dd] = ke[dd] * tot[dd]; }
            *(LAS unsigned*)(L + HG_QE + trow * 272 + 4 * dp) = pk2(qe[0], qe[1]);
            *(LAS unsigned*)(L + HG_KE + trow * 272 + 4 * dp) = pk2(ke[0], ke[1]);
            *(LAS unsigned*)(L + HG_KD + trow * 320 + 4 * dp) = pk2(kd[0], kd[1]);
            *(LAS unsigned*)(L + HG_V + trow * 320 + 4 * dp) = v2[i];
            *(unsigned*)(QE + (size_t)(row0 + trow) * 512 + h * 128 + 2 * dp) = pk2(qe[0] * ecum[0], qe[1] * ecum[1]); }
        if (seg == 0) *(LAS f32x2*)(dec + 2 * dp) = (f32x2){tot[0], tot[1]};
        ecum[0] *= tot[0]; ecum[1] *= tot[1];
        __syncthreads();
        f32x16 X;
#pragma unroll
        for (int r = 0; r < 16; ++r) X[r] = 0.f;
#pragma unroll
        for (int k = 0; k < 4; ++k) { const int dofs = (64 * dh + 16 * k + 8 * hh) * 2;
            const bf16x8 a = *(const LAS bf16x8*)(L + HG_KE + c32 * 272 + dofs); const bf16x8 bq = *(const LAS bf16x8*)(L + HG_QE + c32 * 272 + dofs);
            X = MFMA32(a, bq, X); }
#pragma unroll
        for (int r = 0; r < 16; ++r) X[r] = (crow(r, hh) <= c32) ? X[r] : 0.f;
        f32x16 O;
#pragma unroll
        for (int r = 0; r < 16; ++r) O[r] = 0.f;
#pragma unroll
        for (int s2 = 0; s2 < 2; ++s2) { const LAS unsigned char* vb = L + HG_V + (16 * s2 + 4 * hh + tq) * 320 + (32 * eb + 16 * blk + 4 * tp) * 2;
            const bf16x8 a2 = cat8(tr_read(vb), tr_read(vb + 8 * 320)); O = MFMA32(a2, pack_step(X, s2), O); }
#pragma unroll
        for (int i = 0; i < 2; ++i)
#pragma unroll
            for (int s3 = 0; s3 < 2; ++s3) { const LAS unsigned char* qb = L + HG_QE + c32 * 272 + (32 * (2 * dh + i) + 16 * s3 + 4 * hh) * 2;
                const s16x4 lo = *(const LAS s16x4*)qb, hi = *(const LAS s16x4*)(qb + 16);
                O = MFMA32(pack_step(Sacc[i], s3), cat8(lo, hi), O); }
#pragma unroll
        for (int i = 0; i < 2; ++i) { const int dblk = 2 * dh + i;
#pragma unroll
            for (int r = 0; r < 16; ++r) Sacc[i][r] *= dec[32 * dblk + crow(r, hh)];
#pragma unroll
            for (int st = 0; st < 2; ++st) { const LAS unsigned char* ka = L + HG_KD + (16 * st + 8 * hh + tq) * 320 + (32 * dblk + 16 * blk + 4 * tp) * 2;
                const LAS unsigned char* va = L + HG_V + (16 * st + 8 * hh + tq) * 320 + (32 * eb + 16 * blk + 4 * tp) * 2;
                const bf16x8 a4 = cat8(tr_read(ka), tr_read(ka + 4 * 320)); const bf16x8 b4 = cat8(tr_read(va), tr_read(va + 4 * 320));
                Sacc[i] = MFMA32(a4, b4, Sacc[i]); } }
        if (dh == 1) {
#pragma unroll
            for (int r = 0; r < 16; ++r) op[(eb * 16 + r) * 64 + F.lane] = O[r]; }
        __syncthreads();
        if (dh == 0) {
#pragma unroll
            for (int r = 0; r < 16; ++r) O[r] += op[(eb * 16 + r) * 64 + F.lane];
            bf16_t* orow = OLOC + (size_t)(row0 + c32) * 512 + h * 128 + 32 * eb + 4 * hh;
#pragma unroll
            for (int g = 0; g < 4; ++g) { u32x2 w; w.x = pk2(O[4 * g], O[4 * g + 1]); w.y = pk2(O[4 * g + 2], O[4 * g + 3]); *(u32x2*)(orow + 8 * g) = w; } }
    }
    float* SL = (float*)(F.ws + WS_SLOC) + (size_t)u * 16384;
#pragma unroll
    for (int i = 0; i < 2; ++i)
#pragma unroll
        for (int r = 0; r < 16; ++r) SL[(32 * (2 * dh + i) + crow(r, hh)) * 128 + 32 * eb + c32] = Sacc[i][r];
    if (seg == 0) *(f32x2*)((float*)(F.ws + WS_DTOT) + u * 128 + 2 * dp) = (f32x2){ecum[0], ecum[1]};
    __syncthreads();
}

constexpr int AT_KS = 144, AT_VS = 192, AT_K = 0, AT_V = 384 * 144;
struct AttnU { int n, dil, r, p, b, h; };
__device__ __forceinline__ AttnU attn_decode(int u) {
    AttnU a; a.n = u >> 9; const int rem = u & 511, bh = rem >> 4;
    if (a.n == 0) { a.dil = 1; a.p = rem & 15; a.r = 0; } else if (a.n == 1) { a.dil = 4; a.r = (rem >> 2) & 3; a.p = rem & 3; } else { a.dil = 16; a.r = rem & 15; a.p = 0; }
    a.b = bh >> 3; a.h = bh & 7; return a;
}
__device__ __forceinline__ void attn_load(Ctx& F, const AttnU& a, u32x4 (&kv)[12], bf16x8 (&qf)[4]) {
    const bf16_t* proj = (const bf16_t*)(F.ws + WS_PROJ);
#pragma unroll
    for (int it = 0; it < 12; ++it) { const int idx = F.tid + 512 * (it % 6); const int row = idx >> 3, pc = idx & 7; const int sub = 256 * a.p - 128 + row;
        const int subc = sub < 0 ? 0 : sub;
        const bf16_t* src = proj + (size_t)(a.b * SEQ + subc * a.dil + a.r) * DIN + (it < 6 ? C_KA : C_VA) + a.h * 64 + pc * 8;
        kv[it] = *(const u32x4*)src; }
    const int qsub = 256 * a.p + 32 * F.wave + (F.lane & 31); const size_t grow = (size_t)a.b * SEQ + (size_t)qsub * a.dil + a.r;
#pragma unroll
    for (int k = 0; k < 4; ++k) qf[k] = *(const bf16x8*)(proj + grow * DIN + C_QA + a.h * 64 + 16 * k + 8 * (F.lane >> 5));
}
__device__ __forceinline__ void attn_stage(Ctx& F, const AttnU& a, const u32x4 (&kv)[12]) {
    LAS unsigned char* L = F.lds;
#pragma unroll
    for (int it = 0; it < 12; ++it) { const int idx = F.tid + 512 * (it % 6); const int row = idx >> 3, pc = idx & 7; const int sub = 256 * a.p - 128 + row;
        const u32x4 v = (sub < 0) ? (u32x4){0u, 0u, 0u, 0u} : kv[it];
        if (it < 6) *(LAS u32x4*)(L + AT_K + row * AT_KS + pc * 16) = v; else *(LAS u32x4*)(L + AT_V + row * AT_VS + pc * 16) = v; }
}
__device__ __forceinline__ void attn_compute(Ctx& F, const AttnU& a, const bf16x8 (&qf)[4]) {
    LAS unsigned char* L = F.lds;
    const int w = F.wave, c32 = F.lane & 31, hh = F.lane >> 5;
    const int i16 = F.lane & 15, tq = i16 >> 2, tp = i16 & 3, blk = (F.lane >> 4) & 1;
    const int n = a.n, p = a.p, h = a.h;
    const int qsub = 256 * p + 32 * w + c32; const size_t grow = (size_t)a.b * SEQ + (size_t)qsub * a.dil + a.r;
    const int kb0 = (p == 0 && w < 4) ? (4 - w) : 0;
    f32x16 X[5];
#pragma unroll
    for (int kb = 0; kb < 5; ++kb) {
#pragma unroll
        for (int r16 = 0; r16 < 16; ++r16) X[kb][r16] = 0.f;
        if (kb >= kb0) {
#pragma unroll
            for (int k = 0; k < 4; ++k) { const bf16x8 af = *(const LAS bf16x8*)(L + AT_K + (32 * (w + kb) + c32) * AT_KS + (16 * k + 8 * hh) * 2); X[kb] = MFMA32(af, qf[k], X[kb]); } }
    }
    float m = -INFINITY;
#pragma unroll
    for (int kb = 0; kb < 5; ++kb)
#pragma unroll
        for (int r16 = 0; r16 < 16; ++r16) { const int row = crow(r16, hh);
            bool valid = (kb >= kb0); if (kb == 0) valid = valid && (row >= c32); if (kb == 4) valid = valid && (row <= c32);
            X[kb][r16] = valid ? X[kb][r16] : -INFINITY; m = fmaxf(m, X[kb][r16]); }
    m = fmaxf(m, __shfl_xor(m, 32));
    const float c2 = 0.125f * 1.4426950408889634f;
    float l = 0.f;
#pragma unroll
    for (int kb = 0; kb < 5; ++kb)
#pragma unroll
        for (int r16 = 0; r16 < 16; ++r16) { const float pv = __builtin_amdgcn_exp2f((X[kb][r16] - m) * c2); X[kb][r16] = pv; l += pv; }
    l += __shfl_xor(l, 32);
    f32x16 O[2];
#pragma unroll
    for (int i = 0; i < 2; ++i)
#pragma unroll
        for (int r16 = 0; r16 < 16; ++r16) O[i][r16] = 0.f;
#pragma unroll
    for (int kb = 0; kb < 5; ++kb) {
        if (kb >= kb0) {
#pragma unroll
            for (int s = 0; s < 2; ++s) { const bf16x8 pb = pack_step(X[kb], s);
#pragma unroll
                for (int dhf = 0; dhf < 2; ++dhf) { const LAS unsigned char* vb = L + AT_V + (32 * (w + kb) + 16 * s + 4 * hh + tq) * AT_VS + (32 * dhf + 16 * blk + 4 * tp) * 2;
                    const bf16x8 af = cat8(tr_read(vb), tr_read(vb + 8 * AT_VS)); O[dhf] = MFMA32(af, pb, O[dhf]); } } }
    }
    const float inv = rcpf_(l);
    bf16_t* po = (bf16_t*)(F.ws + WS_PARTO) + ((size_t)n * T + grow) * 512 + h * 64 + 4 * hh;
#pragma unroll
    for (int dhf = 0; dhf < 2; ++dhf)
#pragma unroll
        for (int g = 0; g < 4; ++g) { u32x2 wv; wv.x = pk2(O[dhf][4 * g] * inv, O[dhf][4 * g + 1] * inv); wv.y = pk2(O[dhf][4 * g + 2] * inv, O[dhf][4 * g + 3] * inv);
            *(u32x2*)(po + 32 * dhf + 8 * g) = wv; }
    if (hh == 0) ((float*)(F.ws + WS_LSE))[((size_t)n * T + grow) * 8 + h] = m * 0.125f + __logf(l);
}
__device__ __forceinline__ void attn_units(Ctx& F) {
    int u = F.bid; if (u >= 1536) return;
    u32x4 kv[12]; bf16x8 qf[4], qn[4];
    AttnU a = attn_decode(u);
    attn_load(F, a, kv, qn);
    for (; u < 1536; u += F.G) {
        attn_stage(F, a, kv);
#pragma unroll
        for (int k = 0; k < 4; ++k) qf[k] = qn[k];
        __syncthreads();
        const AttnU cur = a;
        if (u + F.G < 1536) { a = attn_decode(u + F.G); attn_load(F, a, kv, qn); }
        attn_compute(F, cur, qf);
        __syncthreads();
    }
}

__device__ __forceinline__ void p4_scan(Ctx& F) {
    const float* SL = (const float*)(F.ws + WS_SLOC); const float* DT = (const float*)(F.ws + WS_DTOT); bf16_t* SIN = (bf16_t*)(F.ws + WS_SIN);
    for (int unit = F.bid; unit < 256; unit += F.G) {
        const int bh = unit >> 4, bk = unit & 15, db = bk >> 2, ebk = bk & 3;
        const int e = 32 * ebk + (F.tid & 31), d0 = 32 * db + (F.tid >> 5), d1 = d0 + 16;
        float s0 = 0.f, s1 = 0.f;
        for (int j = 0; j < 16; ++j) { const int u = bh * 16 + j;
            SIN[(size_t)u * 16384 + d0 * 128 + e] = (bf16_t)(pk2(s0, 0.f) & 0xffffu); SIN[(size_t)u * 16384 + d1 * 128 + e] = (bf16_t)(pk2(s1, 0.f) & 0xffffu);
            s0 = DT[u * 128 + d0] * s0 + SL[(size_t)u * 16384 + d0 * 128 + e]; s1 = DT[u * 128 + d1] * s1 + SL[(size_t)u * 16384 + d1 * 128 + e]; }
    }
}

__device__ __forceinline__ void p5_fixup_unit(Ctx& F, int u) {
    const int bh = u >> 4, jj = u & 15, b = bh >> 2, h = bh & 3;
    const int rowbase = b * SEQ + jj * 256;
    LAS unsigned char* L = F.lds;
    const bf16_t* SIN = (const bf16_t*)(F.ws + WS_SIN) + (size_t)u * 16384;
    const bf16_t* QE = (const bf16_t*)(F.ws + WS_QE); const bf16_t* OLOC = (const bf16_t*)(F.ws + WS_OLOC); const bf16_t* proj = (const bf16_t*)(F.ws + WS_PROJ);
    bf16_t* YC = (bf16_t*)(F.ws + WS_YCAT);
    const int c32 = F.lane & 31, hh = F.lane >> 5, i16 = F.lane & 15, tq = i16 >> 2, tp = i16 & 3, blk = (F.lane >> 4) & 1;
#pragma unroll
    for (int it = 0; it < 4; ++it) { const int idx = F.tid + 512 * it, row = idx >> 4, pc = idx & 15; *(LAS u32x4*)(L + row * 320 + pc * 16) = *(const u32x4*)(SIN + row * 128 + pc * 8); }
    const size_t tok = (size_t)rowbase + 32 * F.wave + c32;
    bf16x8 bq[8];
#pragma unroll
    for (int k = 0; k < 8; ++k) bq[k] = *(const bf16x8*)(QE + tok * 512 + h * 128 + 16 * k + 8 * hh);
    __syncthreads();
    f32x16 acc[4];
#pragma unroll
    for (int et = 0; et < 4; ++et) {
#pragma unroll
        for (int r = 0; r < 16; ++r) acc[et][r] = 0.f;
#pragma unroll
        for (int k = 0; k < 8; ++k) { const LAS unsigned char* sb = L + (16 * k + 8 * hh + tq) * 320 + (32 * et + 16 * blk + 4 * tp) * 2;
            const bf16x8 a = cat8(tr_read(sb), tr_read(sb + 4 * 320)); acc[et] = MFMA32(a, bq[k], acc[et]); }
    }
    float ss = 0.f;
#pragma unroll
    for (int et = 0; et < 4; ++et)
#pragma unroll
        for (int g = 0; g < 4; ++g) { const int e0 = 32 * et + 8 * g + 4 * hh; const u32x2 ol = *(const u32x2*)(OLOC + tok * 512 + h * 128 + e0);
            acc[et][4 * g] += bflo(ol.x); acc[et][4 * g + 1] += bfhi(ol.x); acc[et][4 * g + 2] += bflo(ol.y); acc[et][4 * g + 3] += bfhi(ol.y);
            ss += (acc[et][4 * g] * acc[et][4 * g] + acc[et][4 * g + 1] * acc[et][4 * g + 1]) + (acc[et][4 * g + 2] * acc[et][4 * g + 2] + acc[et][4 * g + 3] * acc[et][4 * g + 3]); }
    ss += __shfl_xor(ss, 32);
    const float rstd = 1.0f / sqrtf(ss * (1.f / 128.f) + EPS);
#pragma unroll
    for (int et = 0; et < 4; ++et)
#pragma unroll
        for (int g = 0; g < 4; ++g) { const int e0 = 32 * et + 8 * g + 4 * hh; const f32x4 nw = *(const f32x4*)((F.ap->in[9]) + h * 128 + e0);
            const u32x2 g2 = *(const u32x2*)(proj + tok * DIN + C_GR + h * 128 + e0);
            const float ga = bflo(g2.x), gb = bfhi(g2.x), gc = bflo(g2.y), gd = bfhi(g2.y);
            u32x2 wv; wv.x = pk2(acc[et][4 * g] * rstd * nw.x * (ga * sigmoidf_(ga)), acc[et][4 * g + 1] * rstd * nw.y * (gb * sigmoidf_(gb)));
            wv.y = pk2(acc[et][4 * g + 2] * rstd * nw.z * (gc * sigmoidf_(gc)), acc[et][4 * g + 3] * rstd * nw.w * (gd * sigmoidf_(gd)));
            *(u32x2*)(YC + tok * 1024 + 512 + h * 128 + e0) = wv; }
    __syncthreads();
}
__device__ __forceinline__ void p5_attn_merge(Ctx& F) {
    const int gw = F.bid * 8 + F.wave, NGW = F.G * 8;
    const bf16_t* PO = (const bf16_t*)(F.ws + WS_PARTO); const float* LS = (const float*)(F.ws + WS_LSE); bf16_t* YC = (bf16_t*)(F.ws + WS_YCAT);
    const int hd = F.lane >> 3, sub = F.lane & 7;
#pragma unroll 2
    for (int tok = gw; tok < T; tok += NGW) {
        float ls[3]; u32x4 o[3];
#pragma unroll
        for (int n = 0; n < 3; ++n) { ls[n] = LS[((size_t)n * T + tok) * 8 + hd]; o[n] = *(const u32x4*)(PO + ((size_t)n * T + tok) * 512 + hd * 64 + sub * 8); }
        const float mx = fmaxf(ls[0], fmaxf(ls[1], ls[2]));
        float wgt[3]; wgt[0] = __expf(ls[0] - mx); wgt[1] = __expf(ls[1] - mx); wgt[2] = __expf(ls[2] - mx);
        const float inv = 1.f / (wgt[0] + wgt[1] + wgt[2]);
        float v[8];
#pragma unroll
        for (int i = 0; i < 8; ++i) v[i] = 0.f;
#pragma unroll
        for (int n = 0; n < 3; ++n) { const float wn = wgt[n] * inv;
            v[0] += wn * bflo(o[n].x); v[1] += wn * bfhi(o[n].x); v[2] += wn * bflo(o[n].y); v[3] += wn * bfhi(o[n].y);
            v[4] += wn * bflo(o[n].z); v[5] += wn * bfhi(o[n].z); v[6] += wn * bflo(o[n].w); v[7] += wn * bfhi(o[n].w); }
        float ss = 0.f;
#pragma unroll
        for (int i = 0; i < 8; ++i) ss += v[i] * v[i];
        ss += __shfl_xor(ss, 1); ss += __shfl_xor(ss, 2); ss += __shfl_xor(ss, 4);
        const float rstd = 1.0f / sqrtf(ss * (1.f / 64.f) + EPS);
        const f32x4 n0 = *(const f32x4*)((F.ap->in[7]) + hd * 64 + sub * 8), n1 = *(const f32x4*)((F.ap->in[7]) + hd * 64 + sub * 8 + 4);
        u32x4 wv; wv.x = pk2(v[0] * rstd * n0.x, v[1] * rstd * n0.y); wv.y = pk2(v[2] * rstd * n0.z, v[3] * rstd * n0.w);
        wv.z = pk2(v[4] * rstd * n1.x, v[5] * rstd * n1.y); wv.w = pk2(v[6] * rstd * n1.z, v[7] * rstd * n1.w);
        *(u32x4*)(YC + (size_t)tok * 1024 + hd * 64 + sub * 8) = wv;
    }
}

__device__ __forceinline__ void p7_load(Ctx& F, int m, u32x2 (&yb)[4], f32x4 (&xv)[4]) {
    const u32x2* yr = (const u32x2*)((const bf16_t*)(F.ws + WS_Y) + (size_t)m * D) + F.lane;
    const f32x4* xr = (const f32x4*)((F.ap->in[0]) + (size_t)m * D) + F.lane;
#pragma unroll
    for (int j = 0; j < 4; ++j) { yb[j] = yr[64 * j]; xv[j] = xr[64 * j]; }
}
__device__ __forceinline__ void p7_row(Ctx& F, int m, const u32x2 (&yb)[4], f32x4 (&xv)[4]) {
    const float* mod = (const float*)(F.ws + WS_MOD); const int b = m / SEQ;
    f32x4 y[4]; float ss = 0.f;
#pragma unroll
    for (int j = 0; j < 4; ++j) { y[j] = (f32x4){bflo(yb[j].x), bfhi(yb[j].x), bflo(yb[j].y), bfhi(yb[j].y)};
        ss += (y[j].x * y[j].x + y[j].y * y[j].y) + (y[j].z * y[j].z + y[j].w * y[j].w); }
    const float rstd1 = 1.0f / sqrtf(wave_sum(ss) * (1.f / D) + EPS);
    u32x2* x2o = (u32x2*)((bf16_t*)(F.ws + WS_X2) + (size_t)m * D) + F.lane;
    float ss2 = 0.f;
#pragma unroll
    for (int j = 0; j < 4; ++j) { const int k = 4 * F.lane + 256 * j;
        const f32x4 gp = *(const f32x4*)((F.ap->in[5]) + k), gm = *(const f32x4*)(mod + b * 6144 + 2048 + k);
        xv[j] = xv[j] + gm * (y[j] * rstd1 * gp); { u32x2 w2; w2.x = pk2(xv[j].x, xv[j].y); w2.y = pk2(xv[j].z, xv[j].w); x2o[64 * j] = w2; }
        ss2 += (xv[j].x * xv[j].x + xv[j].y * xv[j].y) + (xv[j].z * xv[j].z + xv[j].w * xv[j].w); }
    const float rstd2 = 1.0f / sqrtf(wave_sum(ss2) * (1.f / D) + EPS);
    u32x2* ho = (u32x2*)((bf16_t*)(F.ws + WS_H) + (size_t)m * D) + F.lane;
    u32x2* hl = (u32x2*)((bf16_t*)(F.ws + WS_HLO) + (size_t)m * D) + F.lane;
#pragma unroll
    for (int j = 0; j < 4; ++j) { const int k = 4 * F.lane + 256 * j;
        const f32x4 g = *(const f32x4*)((F.ap->in[11]) + k), sh = *(const f32x4*)(mod + b * 6144 + 3072 + k), sc = *(const f32x4*)(mod + b * 6144 + 4096 + k);
        const f32x4 hx = xv[j] * rstd2 * g * (sc + 1.0f) + sh;
        u32x2 w; w.x = pk2(hx.x, hx.y); w.y = pk2(hx.z, hx.w); ho[64 * j] = w;
        u32x2 l; l.x = pk2(hx.x - bflo(w.x), hx.y - bfhi(w.x)); l.y = pk2(hx.z - bflo(w.y), hx.w - bfhi(w.y)); hl[64 * j] = l;
        if (MOE_FP8) ((unsigned*)((unsigned char*)(F.ws + WS_H8) + (size_t)m * D) + F.lane)[64 * j] = pk4_fp8(hx.x * F8_SA, hx.y * F8_SA, hx.z * F8_SA, hx.w * F8_SA); }
}
__device__ __forceinline__ void p7_rows(Ctx& F) {
    LAS float* part = (LAS float*)F.lds;
    LAS int* hist = (LAS int*)(F.lds + MISC_OFF); LAS int* gbase = hist + 32; LAS int* pbp = hist + 64; LAS int* pbe = hist + 64 + 256; LAS float* pbg = (LAS float*)(hist + 64 + 512);
    unsigned* cnt = (unsigned*)(F.ws + WS_CTL) + CW_CNT; u32x2* TOK = (u32x2*)(F.ws + WS_TOK);
    const bf16_t* H = (const bf16_t*)(F.ws + WS_H); const bf16_t* HLO = (const bf16_t*)(F.ws + WS_HLO); const bf16_t* WRT = (const bf16_t*)(F.ws + WS_WRT);
    const int c32 = F.lane & 31, hh = F.lane >> 5, tt = F.wave & 1, kq = F.wave >> 1;
    for (int rb = F.bid; rb < T / 64; rb += F.G) {
        if (F.tid < 32) hist[F.tid] = 0;
        { u32x2 nyb[4]; f32x4 nxv[4]; p7_load(F, rb * 64 + F.wave * 8, nyb, nxv);
          for (int i = 0; i < 8; ++i) { u32x2 yb[4]; f32x4 xv[4];
#pragma unroll
              for (int j = 0; j < 4; ++j) { yb[j] = nyb[j]; xv[j] = nxv[j]; }
              if (i < 7) p7_load(F, rb * 64 + F.wave * 8 + i + 1, nyb, nxv);
              p7_row(F, rb * 64 + F.wave * 8 + i, yb, xv); } }
        asm volatile("s_waitcnt vmcnt(0)" ::: "memory");
        __syncthreads();
        const size_t tok = (size_t)rb * 64 + 32 * tt + c32;
        f32x16 acc;
#pragma unroll
        for (int r = 0; r < 16; ++r) acc[r] = 0.f;
#pragma unroll 4
        for (int s = 0; s < 16; ++s) { const int k0 = 256 * kq + 16 * s + 8 * hh;
            const bf16x8 bh = *(const bf16x8*)(H + tok * 1024 + k0), bl = *(const bf16x8*)(HLO + tok * 1024 + k0);
            const bf16x8 ah = *(const bf16x8*)(WRT + c32 * 1024 + k0), al = *(const bf16x8*)(WRT + 32768 + c32 * 1024 + k0);
            acc = MFMA32(ah, bh, acc); acc = MFMA32(ah, bl, acc); acc = MFMA32(al, bh, acc); }
#pragma unroll
        for (int r = 0; r < 16; ++r) part[(F.wave * 16 + r) * 64 + F.lane] = acc[r];
        __syncthreads();
        if (kq == 0) {
            float v[16];
#pragma unroll
            for (int r = 0; r < 16; ++r) v[r] = part[((0 * 2 + tt) * 16 + r) * 64 + F.lane] + part[((1 * 2 + tt) * 16 + r) * 64 + F.lane] + part[((2 * 2 + tt) * 16 + r) * 64 + F.lane] + part[((3 * 2 + tt) * 16 + r) * 64 + F.lane] + (F.ap->in[14])[crow(r, hh)];
            float cv[8]; int ci[8];
#pragma unroll
            for (int kk = 0; kk < 4; ++kk) { float best = -INFINITY; int bi = 0;
#pragma unroll
                for (int r = 0; r < 16; ++r) { const bool gt = v[r] > best; best = gt ? v[r] : best; bi = gt ? crow(r, hh) : bi; }
                cv[kk] = best; ci[kk] = bi;
#pragma unroll
                for (int r = 0; r < 16; ++r) v[r] = (crow(r, hh) == bi) ? -INFINITY : v[r]; }
#pragma unroll
            for (int kk = 0; kk < 4; ++kk) { cv[4 + kk] = __shfl_xor(cv[kk], 32); ci[4 + kk] = __shfl_xor(ci[kk], 32); }
            float val[4]; int idx[4];
#pragma unroll
            for (int kk = 0; kk < 4; ++kk) { float best = -INFINITY; int bi = 1 << 20;
#pragma unroll
                for (int q = 0; q < 8; ++q) { const bool gt = (cv[q] > best) || (cv[q] == best && ci[q] < bi); best = gt ? cv[q] : best; bi = gt ? ci[q] : bi; }
                val[kk] = best; idx[kk] = bi;
#pragma unroll
                for (int q = 0; q < 8; ++q) cv[q] = (ci[q] == bi) ? -INFINITY : cv[q]; }
            float g[4]; float sg = 0.f;
#pragma unroll
            for (int kk = 0; kk < 4; ++kk) { g[kk] = __expf(val[kk] - val[0]); sg += g[kk]; }
            const float inv = 1.f / sg;
            if (hh == 0) { const int mloc = 32 * tt + c32; const int m = rb * 64 + mloc;
#pragma unroll
                for (int kk = 0; kk < 4; ++kk) { const int rank = atomicAdd((int*)(hist + idx[kk]), 1); const int slot = mloc * 4 + kk;
                    pbp[slot] = m * 4 + kk; pbe[slot] = idx[kk] | (rank << 8); pbg[slot] = g[kk] * inv; } }
        }
        __syncthreads();
        if (F.tid < 32) gbase[F.tid] = (int)atomicAdd(cnt + 64 * F.tid, (unsigned)hist[F.tid]);
        __syncthreads();
        if (F.tid < 256) { const int e = pbe[F.tid] & 255, rank = pbe[F.tid] >> 8; TOK[e * LIST_CAP + gbase[e] + rank] = (u32x2){(unsigned)pbp[F.tid], __float_as_uint(pbg[F.tid])}; }
        __syncthreads();
    }
}

__device__ __forceinline__ void moe_tables(Ctx& F, LAS int* cntl, LAS int* tbase, LAS int* tile_e) {
    const unsigned* cnt = (const unsigned*)(F.ws + WS_CTL) + CW_CNT;
    if (F.tid < NE) cntl[F.tid] = (int)__hip_atomic_load(cnt + 64 * F.tid, __ATOMIC_RELAXED, __HIP_MEMORY_SCOPE_AGENT);
    __syncthreads();
    if (F.tid <= NE) { int base = 0;
        for (int e = 0; e < F.tid; ++e) base += (cntl[e] + 255) >> 8;
        tbase[F.tid] = base; }
    __syncthreads();
    if (F.tid < 320) { int e = 0;
        for (int q = 1; q < NE; ++q) e = (tbase[q] <= F.tid) ? q : e;
        tile_e[F.tid] = e; }
    __syncthreads();
}

__device__ __forceinline__ void p10_load(Ctx& F, int m, u32x2 (&yp)[4][4], u32x2 (&xv)[4]) {
    const bf16_t* YP = (const bf16_t*)(F.ws + WS_YPAIR); const bf16_t* X2 = (const bf16_t*)(F.ws + WS_X2);
#pragma unroll
    for (int j = 0; j < 4; ++j) {
#pragma unroll
        for (int kk = 0; kk < 4; ++kk) yp[j][kk] = *((const u32x2*)(YP + ((size_t)m * 4 + kk) * 1024) + F.lane + 64 * j);
        xv[j] = ((const u32x2*)(X2 + (size_t)m * D) + F.lane)[64 * j]; }
}
__device__ __forceinline__ void p10_final(Ctx& F) {
    const int gw = F.bid * 8 + F.wave, NGW = F.G * 8;
    const float* mod = (const float*)(F.ws + WS_MOD);
    u32x2 nyp[4][4]; u32x2 nxv[4];
    if (gw < T) p10_load(F, gw, nyp, nxv);
    for (int m = gw; m < T; m += NGW) {
        const int b = m / SEQ;
        f32x4 y[4], xv[4]; float ss = 0.f;
#pragma unroll
        for (int j = 0; j < 4; ++j) { y[j] = (f32x4){0.f, 0.f, 0.f, 0.f}; xv[j] = (f32x4){bflo(nxv[j].x), bfhi(nxv[j].x), bflo(nxv[j].y), bfhi(nxv[j].y)};
#pragma unroll
            for (int kk = 0; kk < 4; ++kk) { const u32x2 v = nyp[j][kk]; y[j].x += bflo(v.x); y[j].y += bfhi(v.x); y[j].z += bflo(v.y); y[j].w += bfhi(v.y); }
            ss += (y[j].x * y[j].x + y[j].y * y[j].y) + (y[j].z * y[j].z + y[j].w * y[j].w); }
        if (m + NGW < T) p10_load(F, m + NGW, nyp, nxv);
        const float rstd = 1.0f / sqrtf(wave_sum(ss) * (1.f / D) + EPS);
        f32x4* o = (f32x4*)((F.ap->out) + (size_t)m * D) + F.lane;
#pragma unroll
        for (int j = 0; j < 4; ++j) { const int k = 4 * F.lane + 256 * j;
            const f32x4 gp = *(const f32x4*)((F.ap->in[12]) + k), gf = *(const f32x4*)(mod + b * 6144 + 5120 + k);
            o[64 * j] = xv[j] + gf * (y[j] * rstd * gp); }
    }
}

__device__ __forceinline__ bool relaunder(Ctx& F) { CArgs p = (CArgs)__builtin_amdgcn_kernarg_segment_ptr(); asm volatile("" : "+s"(p)); F.ap = p; return true; }
__global__ void __launch_bounds__(512, 2) fwd(Args args) {
    extern __shared__ __attribute__((aligned(16))) unsigned char lds_raw[];
    Ctx F;
    F.lds = (LAS unsigned char*)lds_raw;
    F.tid = threadIdx.x; F.lane = F.tid & 63; F.wave = __builtin_amdgcn_readfirstlane(F.tid >> 6); F.G = gridDim.x; F.bid = blockIdx.x;
    F.ap = (CArgs)__builtin_amdgcn_kernarg_segment_ptr(); F.ws = F.ap->ws;
    volatile LAS unsigned* barw = (volatile LAS unsigned*)(F.lds + BARW_OFF);
    if (F.tid < 4) barw[F.tid] = 0u;
    __syncthreads();
    XcdBarrier bar; bar.bar = (unsigned*)(F.ws + WS_CTL) + CW_BAR; bar.x = 0; bar.st = barw;
    if (MK_N_LAUNCHES == 1) bar = xcd_barrier_post((unsigned*)(F.ws + WS_CTL) + CW_BAR, barw);
    const int lo = F.ap->ph_lo, hi = F.ap->ph_hi; (void)args;
#ifndef PH_MASK
#define PH_MASK 0x7ff
#endif
#define IN(k) ((((PH_MASK) >> (k)) & 1) && lo <= (k) && (k) < hi && relaunder(F))
#define SEAM(k) do { if (IN(k) && IN((k) + 1)) xcd_barrier(bar); } while (0)

#ifndef REPEAT_MASK
#define REPEAT_MASK 0
#endif
#define NREP(k) ((((REPEAT_MASK) >> (k)) & 1) ? 2 : 1)
#define REPBAR(rep) do { if (rep) xcd_barrier(bar); } while (0)
    if (IN(0)) { _Pragma("unroll") for (int rep = 0; rep < NREP(0); ++rep) { REPBAR(rep); p0_prologue(F); } } SEAM(0);
    if (IN(1)) { _Pragma("unroll") for (int rep = 0; rep < NREP(1); ++rep) { REPBAR(rep); p1_norm_mod(F); } } SEAM(1);
    if (IN(2)) { _Pragma("unroll") for (int rep = 0; rep < NREP(2); ++rep) { REPBAR(rep);
        pg8::ProbPlain<G1_FP8 ? 1 : 2> P{(const void*)(F.ws + WS_H), (const void*)(F.ws + WS_WIN)}; pg8::StaticOrder S; S.init(T, DIN, F.G, F.bid);
        pg8::EpiBf16 E{(bf16_t*)(F.ws + WS_PROJ), DIN, G1_FP8 ? 1.f / (F8_SA * F8_SW) : 1.f};
        pg8::gemm_phase<pg8::EpiBf16, pg8::StaticOrder, pg8::ProbPlain<G1_FP8 ? 1 : 2>>(F.lds, P, S, E);
    } } SEAM(2);
    if (IN(3)) { _Pragma("unroll") for (int rep = 0; rep < NREP(3); ++rep) { REPBAR(rep);
        for (int u = F.bid; u < 256; u += F.G) hgrn_local_unit(F, u);
        if ((REPEAT_MASK) & 2048) { xcd_barrier(bar); for (int u = F.bid; u < 256; u += F.G) hgrn_local_unit(F, u); }
        attn_units(F);
        if ((REPEAT_MASK) & 4096) { xcd_barrier(bar); attn_units(F); }
    } } SEAM(3);
    if (IN(4)) { _Pragma("unroll") for (int rep = 0; rep < NREP(4); ++rep) { REPBAR(rep); p4_scan(F); } } SEAM(4);
    if (IN(5)) { _Pragma("unroll") for (int rep = 0; rep < NREP(5); ++rep) { REPBAR(rep);
        for (int u = F.bid; u < 256; u += F.G) p5_fixup_unit(F, u);
        p5_attn_merge(F);
    } } SEAM(5);
    if (IN(6)) { _Pragma("unroll") for (int rep = 0; rep < NREP(6); ++rep) { REPBAR(rep);
        pg8::ProbPlain<2> P{(const void*)(F.ws + WS_YCAT), (const void*)(F.ws + WS_WOUT)}; pg8::StaticOrder S; S.init(T, D, F.G, F.bid);
        pg8::EpiBf16 E{(bf16_t*)(F.ws + WS_Y), D, 1.f};
        pg8::gemm_phase<pg8::EpiBf16, pg8::StaticOrder, pg8::ProbPlain<2>>(F.lds, P, S, E);
    } } SEAM(6);
    if (IN(7)) { p7_rows(F); } SEAM(7);
    if (IN(8)) { _Pragma("unroll") for (int rep = 0; rep < NREP(8); ++rep) { REPBAR(rep);
        LAS int* cntl = (LAS int*)(F.lds + MISC_OFF); LAS int* tbase = cntl + 32; LAS int* tile_e = cntl + 128;
        moe_tables(F, cntl, tbase, tile_e);
        pg8::ProbGU<MOE_FP8 ? 1 : 2> P{(const void*)(F.ws + (MOE_FP8 ? WS_H8 : WS_H)), (const void*)(F.ws + WS_WGU), (const int*)(F.ws + WS_TOK)};
        pg8::MoeOrder S{cntl, tbase, tile_e, 8, F.G, F.bid};
        pg8::EpiGU<MOE_FP8 != 0> E{(void*)(F.ws + WS_ACT), (F.ap->in[16])};
        pg8::gemm_phase<pg8::EpiGU<MOE_FP8 != 0>, pg8::MoeOrder, pg8::ProbGU<MOE_FP8 ? 1 : 2>>(F.lds, P, S, E);
    } } SEAM(8);
    if (IN(9)) { _Pragma("unroll") for (int rep = 0; rep < NREP(9); ++rep) { REPBAR(rep);
        LAS int* cntl = (LAS int*)(F.lds + MISC_OFF); LAS int* tbase = cntl + 32; LAS int* tile_e = cntl + 128;
        moe_tables(F, cntl, tbase, tile_e);
        pg8::ProbDown<MOE_FP8 ? 1 : 2> P{(const void*)(F.ws + WS_ACT), (const void*)(F.ws + WS_WDN)};
        pg8::MoeOrder S{cntl, tbase, tile_e, 4, F.G, F.bid};
        pg8::EpiDown<MOE_FP8 != 0> E{(bf16_t*)(F.ws + WS_YPAIR), (F.ap->in[18]), (const int*)(F.ws + WS_TOK)};
        pg8::gemm_phase<pg8::EpiDown<MOE_FP8 != 0>, pg8::MoeOrder, pg8::ProbDown<MOE_FP8 ? 1 : 2>>(F.lds, P, S, E);
    } } SEAM(9);
    if (IN(10)) { _Pragma("unroll") for (int rep = 0; rep < NREP(10); ++rep) { REPBAR(rep); p10_final(F); } }
#undef IN
#undef SEAM
}

extern "C" void kernel_launch(void* const* d_in, const int* in_sizes, int n_in, void* d_out, int out_size, void* d_ws, size_t ws_size, hipStream_t stream) {
    static int grid = 0;
    if (grid == 0) {
        if (n_in != 19 || out_size != T * D || ws_size < WS_END) { fprintf(stderr, "kernel_launch: unexpected problem (n_in %d, out %d, ws %zu)\n", n_in, out_size, ws_size); grid = -1; return; }
        int dev = 0, cus = 0, per_cu = 0;
        if (hipGetDevice(&dev) != hipSuccess || hipDeviceGetAttribute(&cus, hipDeviceAttributeMultiprocessorCount, dev) != hipSuccess) { grid = -1; return; }
        if (hipFuncSetAttribute((const void*)fwd, hipFuncAttributeMaxDynamicSharedMemorySize, LDS_BYTES) != hipSuccess) { fprintf(stderr, "kernel_launch: hipFuncSetAttribute failed\n"); grid = -1; return; }
        if (hipOccupancyMaxActiveBlocksPerMultiprocessor(&per_cu, (const void*)fwd, 512, LDS_BYTES) != hipSuccess || per_cu < 1) { fprintf(stderr, "kernel_launch: occupancy query reports %d\n", per_cu); }
        (void)hipGetLastError();
        grid = cus;
    }
    if (grid < 0) return;
    (void)hipMemsetAsync((char*)d_ws + WS_CTL, 0, CTL_ZERO_BYTES, stream);
    Args a{};
    for (int i = 0; i < 19; ++i) a.in[i] = (const float*)d_in[i];
    a.out = (float*)d_out; a.ws = (unsigned char*)d_ws;
#if MK_N_LAUNCHES == 1
#ifdef PROBE_PREFIX
    a.ph_lo = 0; a.ph_hi = PROBE_PREFIX;
    hipLaunchKernelGGL(fwd, dim3(grid), dim3(512), LDS_BYTES, stream, a);
    (void)hipMemsetAsync((char*)d_ws + WS_CTL, 0, CTL_ZERO_BYTES, stream);
#endif
    a.ph_lo = 0; a.ph_hi = NPHASE;
    hipLaunchKernelGGL(fwd, dim3(grid), dim3(512), LDS_BYTES, stream, a);
#else
    for (int li = 0; li < NPHASE; ++li) { a.ph_lo = li; a.ph_hi = li + 1; hipLaunchKernelGGL(fwd, dim3(grid), dim3(512), LDS_BYTES, stream, a); }
#endif
}
```

```cpp
#include <hip/hip_runtime.h>
#include <cstdio>
#include <cstdint>

#ifndef MK_N_LAUNCHES
#define MK_N_LAUNCHES 1
#endif

#ifndef MOE_FP8
#define MOE_FP8 1
#endif
#ifndef G1_FP8
#define G1_FP8 1
#endif
#define LAS __attribute__((address_space(3)))
#define GAS __attribute__((address_space(1)))
typedef unsigned short bf16_t;
typedef short bf16x8 __attribute__((ext_vector_type(8)));
typedef short s16x4 __attribute__((ext_vector_type(4)));
typedef short v4i16_t __attribute__((ext_vector_type(4)));
typedef float f32x2 __attribute__((ext_vector_type(2)));
typedef float f32x4 __attribute__((ext_vector_type(4)));
typedef float f32x16 __attribute__((ext_vector_type(16)));
typedef unsigned u32x2 __attribute__((ext_vector_type(2)));
typedef unsigned u32x4 __attribute__((ext_vector_type(4)));
typedef __bf16 bf16x2_t __attribute__((ext_vector_type(2)));
typedef int v8i32 __attribute__((ext_vector_type(8)));
typedef unsigned u32x8 __attribute__((ext_vector_type(8)));

constexpr int D = 1024, NB = 4, SEQ = 4096, T = NB * SEQ;
constexpr int DIN = 3584;
constexpr int C_QA = 0, C_KA = 512, C_VA = 1024, C_QR = 1536, C_FR = 2048, C_IR = 2560, C_GR = 3072;
constexpr int NE = 32;
constexpr float EPS = 1e-6f;
constexpr int NPHASE = 11;
constexpr int LIST_CAP = 16384;
constexpr int ACT_ROWS = T * 4 + NE * 256;

constexpr size_t MiB = 1u << 20;
constexpr size_t WS_CTL = 0, CTL_ZERO_BYTES = 1 * MiB;
constexpr size_t WS_MOD = 1 * MiB;
constexpr size_t WS_WIN = 2 * MiB;
constexpr size_t WS_WOUT = 10 * MiB;
constexpr size_t WS_WRT = 12 * MiB;
constexpr size_t WS_IDENT = 13 * MiB;
constexpr size_t WS_WGU = 16 * MiB;
constexpr size_t WS_WDN = 144 * MiB;
constexpr size_t WS_H = 208 * MiB;
constexpr size_t WS_PROJ = 240 * MiB;
constexpr size_t WS_YCAT = 352 * MiB;
constexpr size_t WS_H8 = 320 * MiB;
constexpr size_t WS_HLO = 240 * MiB;
constexpr size_t WS_ACT = 240 * MiB;
constexpr size_t WS_PARTO = 384 * MiB;
constexpr size_t WS_LSE = 432 * MiB;
constexpr size_t WS_OLOC = 434 * MiB;
constexpr size_t WS_QE = 450 * MiB;
constexpr size_t WS_SLOC = 466 * MiB;
constexpr size_t WS_DTOT = 482 * MiB;
constexpr size_t WS_SIN = 483 * MiB;
constexpr size_t WS_Y = 492 * MiB;
constexpr size_t WS_YPAIR = 384 * MiB;
constexpr size_t WS_X2 = 556 * MiB;
constexpr size_t WS_TOK = 620 * MiB;
constexpr size_t WS_END = 624 * MiB;
static_assert(WS_ACT + (size_t)ACT_ROWS * 2048 <= WS_PARTO, "act overlay");
static_assert(WS_YPAIR + (size_t)T * 4 * 2048 <= WS_X2, "ypair overlay");

constexpr int CW_TMO = 0;
constexpr int CW_BAR = 4096;
constexpr int CW_CNT = 8192;

constexpr int RING_BYTES = 131072;
constexpr int MISC_OFF = RING_BYTES;
constexpr int IDXBUF_OFF = RING_BYTES + 8192;
constexpr int BARW_OFF = RING_BYTES + 16384 - 16;
constexpr int LDS_BYTES = RING_BYTES + 16384;

constexpr float F8_SA = 32.f, F8_SACT = 4.f, F8_SW = 1024.f;
__device__ __forceinline__ unsigned pk4_fp8_nc(float a, float b, float c, float d) {
    int v = 0; v = __builtin_amdgcn_cvt_pk_fp8_f32(a, b, v, false); v = __builtin_amdgcn_cvt_pk_fp8_f32(c, d, v, true); return (unsigned)v;
}
__device__ __forceinline__ unsigned pk4_fp8(float a, float b, float c, float d) {
    a = __builtin_amdgcn_fmed3f(a, -448.f, 448.f); b = __builtin_amdgcn_fmed3f(b, -448.f, 448.f); c = __builtin_amdgcn_fmed3f(c, -448.f, 448.f); d = __builtin_amdgcn_fmed3f(d, -448.f, 448.f);
    int v = 0; v = __builtin_amdgcn_cvt_pk_fp8_f32(a, b, v, false); v = __builtin_amdgcn_cvt_pk_fp8_f32(c, d, v, true); return (unsigned)v;
}
__device__ __forceinline__ float bf2f(unsigned v) { return __uint_as_float(v << 16); }
__device__ __forceinline__ float bflo(unsigned v) { return __uint_as_float(v << 16); }
__device__ __forceinline__ float bfhi(unsigned v) { return __uint_as_float(v & 0xffff0000u); }
__device__ __forceinline__ unsigned pk2(float lo, float hi) { f32x2 v = {lo, hi}; bf16x2_t b = __builtin_convertvector(v, bf16x2_t); return __builtin_bit_cast(unsigned, b); }
__device__ __forceinline__ float wave_sum(float v) {
#pragma unroll
    for (int o = 32; o >= 1; o >>= 1) v += __shfl_xor(v, o);
    return v;
}
__device__ __forceinline__ float rcpf_(float x) { return __builtin_amdgcn_rcpf(x); }
__device__ __forceinline__ float sigmoidf_(float x) { return __builtin_amdgcn_rcpf(1.f + __builtin_amdgcn_exp2f(-1.4426950408889634f * x)); }
__device__ __forceinline__ int crow(int r, int hi) { return (r & 3) + 8 * (r >> 2) + 4 * hi; }
__device__ __forceinline__ s16x4 tr_read(const LAS unsigned char* p) { return __builtin_bit_cast(s16x4, __builtin_amdgcn_ds_read_tr16_b64_v4i16((LAS v4i16_t*)p)); }
__device__ __forceinline__ bf16x8 cat8(s16x4 lo, s16x4 hi) { return (bf16x8){lo[0], lo[1], lo[2], lo[3], hi[0], hi[1], hi[2], hi[3]}; }
__device__ __forceinline__ bf16x8 pack_step(const f32x16& x, int s) {
    u32x4 p; p.x = pk2(x[8 * s], x[8 * s + 1]); p.y = pk2(x[8 * s + 2], x[8 * s + 3]); p.z = pk2(x[8 * s + 4], x[8 * s + 5]); p.w = pk2(x[8 * s + 6], x[8 * s + 7]);
    return __builtin_bit_cast(bf16x8, p);
}
#define MFMA32(a, b, c) __builtin_amdgcn_mfma_f32_32x32x16_bf16((a), (b), (c), 0, 0, 0)

#define XB_TMO      128
#define XB_XCNT(j)  (256  + 64 * (j))
#define XB_XSUB(j)  (1280 + 64 * (j))
#define XB_XGEN(j)  (2304 + 64 * (j))
#define XB_TOP      3328
#define XB_TOPGEN   3392
#define XCD_BAR_WORDS 3456
#define XB_SPIN_CAP (1u << 18)
__device__ __forceinline__ unsigned xb_ld(unsigned* p)              { return __hip_atomic_load(p, __ATOMIC_RELAXED, __HIP_MEMORY_SCOPE_AGENT); }
__device__ __forceinline__ unsigned xb_add(unsigned* p, unsigned v) { return __hip_atomic_fetch_add(p, v, __ATOMIC_RELAXED, __HIP_MEMORY_SCOPE_AGENT); }
__device__ __forceinline__ unsigned xb_xcc_id() { return (unsigned)__builtin_amdgcn_s_getreg((3 << 11) | 20) & 0xFu; }
#define XB_SPIN(cond, bar) do { unsigned _sp = 0; while (cond) { __builtin_amdgcn_s_sleep(1); \
    if ((++_sp & 255u) == 0u) { if (xb_ld(&(bar)[XB_TMO])) break; if (_sp > XB_SPIN_CAP) { atomicAdd(&(bar)[XB_TMO], 1u); break; } } } } while (0)
struct XcdBarrier { unsigned* bar; unsigned x; volatile LAS unsigned* st; };
__device__ __forceinline__ XcdBarrier xcd_barrier_post(unsigned* bar, volatile LAS unsigned* st) {
    XcdBarrier b; b.bar = bar; b.x = xb_xcc_id(); b.st = st;
    if (threadIdx.x == 0) (void)xb_add(&bar[XB_XCNT(b.x)], 1u);
    return b;
}
__device__ __forceinline__ void xcd_barrier_complete(unsigned* bar, unsigned x, unsigned& nloc, unsigned& nx) {
    const unsigned G = gridDim.x * gridDim.y * gridDim.z;
    unsigned sum, cnt, mine, sp = 0u;
    for (;;) {
        sum = 0u; cnt = 0u; mine = 0u;
#pragma unroll
        for (unsigned j = 0; j < 16; ++j) { const unsigned c = xb_ld(&bar[XB_XCNT(j)]); sum += c; cnt += (c > 0u) ? 1u : 0u; mine = (j == x) ? c : mine; }
        if (sum == G) break;
        __builtin_amdgcn_s_sleep(1);
        if ((++sp & 255u) == 0u) { if (xb_ld(&bar[XB_TMO])) break; if (sp > XB_SPIN_CAP) { atomicAdd(&bar[XB_TMO], 1u); break; } }
    }
    nloc = mine > 0u ? mine : 1u; nx = cnt > 0u ? cnt : 1u;
}
__device__ __forceinline__ void xcd_barrier(const XcdBarrier& b) {
    asm volatile("s_waitcnt vmcnt(0)" ::: "memory");
    __syncthreads();
    if (threadIdx.x == 0) {
        unsigned* bar = b.bar;
        __builtin_amdgcn_s_waitcnt(0);
        unsigned nloc = b.st[0], nx = b.st[1];
        if (nloc == 0u) { xcd_barrier_complete(bar, b.x, nloc, nx); b.st[0] = nloc; b.st[1] = nx; }
        const unsigned old = xb_add(&bar[XB_XSUB(b.x)], 1u);
        const unsigned gen = old / nloc;
        if (old + 1u == (gen + 1u) * nloc) {
            __builtin_amdgcn_fence(__ATOMIC_RELEASE, "agent");
            asm volatile("s_waitcnt vmcnt(0)" ::: "memory");
            const unsigned og = xb_add(&bar[XB_TOP], 1u);
            const unsigned tg = og / nx;
            if (og + 1u == (tg + 1u) * nx) xb_add(&bar[XB_TOPGEN], 1u);
            else XB_SPIN(xb_ld(&bar[XB_TOPGEN]) == tg, bar);
            __builtin_amdgcn_fence(__ATOMIC_ACQUIRE, "agent");
            xb_add(&bar[XB_XGEN(b.x)], 1u);
            asm volatile("s_waitcnt vmcnt(0)" ::: "memory");
        } else {
            XB_SPIN(xb_ld(&bar[XB_XGEN(b.x)]) == gen, bar);
            __builtin_amdgcn_fence(__ATOMIC_ACQUIRE, "agent");
            asm volatile("s_waitcnt vmcnt(0)" ::: "memory");
        }
    }
    __syncthreads();
}

namespace pg8 {
constexpr int BM = 256, BK = 64, HALF = 128, HTB = HALF * BK * 2, NXCD = 8, WGM = 8, KD = 1024;
__host__ __device__ __forceinline__ int lds_byte(int r, int c) { const int st = (r >> 4) * 2 + (c >> 5), rr = r & 15, cc = c & 31, ob = rr * 64 + cc * 2; return st * 1024 + (ob ^ (((ob >> 9) & 1) << 5)); }
__host__ __device__ __forceinline__ void stage_rc(int b, int& R, int& C) { const int st = b / 1024, sb = b % 1024, swz = sb ^ (((sb >> 9) & 1) << 5); R = (st >> 1) * 16 + swz / 64; C = (st & 1) * 32 + (swz % 64) / 2; }
__host__ __device__ __forceinline__ int perm32(int rho) { const int n = rho >> 4, i = rho & 15; return 8 * (i >> 2) + 4 * n + (i & 3); }

struct Unit { int pm, pn, e, rt, nvalid; };

struct StaticOrder {
    int nM, nN, nwg, G, c;
    __device__ void init(int M, int N, int G_, int c_) { nM = M / BM; nN = N / BM; nwg = nM * nN; G = G_; c = c_; }
    __device__ bool next(int i, Unit& u) const {
        const long L = (long)i * G + c; if (L >= nwg) return false;
        int wgid = (int)L; { const int q = nwg / NXCD, r = nwg % NXCD, xcd = wgid % NXCD, off = wgid / NXCD; wgid = (xcd < r ? xcd * (q + 1) : r * (q + 1) + (xcd - r) * q) + off; }
        const int nig = WGM * nN, gid = wgid / nig, fm = gid * WGM, gsz = (nM - fm) < WGM ? (nM - fm) : WGM;
        u.pm = fm + ((wgid % nig) % gsz); u.pn = (wgid % nig) / gsz; u.e = 0; u.rt = 0; u.nvalid = 256; return true;
    }
};
struct MoeOrder { static constexpr bool IS_MOE = true;
    const LAS int* cnt; const LAS int* tbase; const LAS int* tile_e; int ncol, G, c;
    __device__ bool next(int i, Unit& u) const {
        const int ng = (G % 8 == 0) ? 8 : 1, nl = G / ng, x = c % ng, j = c / ng, NT = tbase[NE];
        const int t0 = (x * NT) / ng, t1 = ((x + 1) * NT) / ng; const int pos = i * nl + j;
        if (pos >= (t1 - t0) * ncol) return false;
        const int gt = t0 + pos / ncol; const int e = tile_e[gt];
        u.e = __builtin_amdgcn_readfirstlane(e); u.rt = __builtin_amdgcn_readfirstlane(gt - tbase[e]); u.pn = __builtin_amdgcn_readfirstlane(pos % ncol);
        u.pm = __builtin_amdgcn_readfirstlane(gt); const int left = cnt[e] - u.rt * 256; u.nvalid = __builtin_amdgcn_readfirstlane(left < 256 ? left : 256); return true;
    }
};
template <int ELT_> struct ProbPlain {
    static constexpr bool GATHER = (ELT_ == 1), SWZ8 = (ELT_ == 1), CLAMP = false; static constexpr int ELT = ELT_;
    const void* A; const void* Bt; const int* ident;
    __device__ __forceinline__ const char* a_ptr(const Unit& u) const { return GATHER ? (const char*)A : (const char*)A + (size_t)u.pm * (256 * KD * ELT); }
    __device__ __forceinline__ const char* b_ptr(const Unit& u) const { return (const char*)Bt + (size_t)u.pn * (256 * KD * ELT); }
    __device__ __forceinline__ const int* list_ptr(const Unit& u) const { return ident + 2 * ((size_t)u.pm * 256); }
};
template <int ELT_> struct ProbGU {
    static constexpr bool GATHER = true, SWZ8 = true, CLAMP = true; static constexpr int ELT = ELT_;
    const void* A; const void* Bt; const int* list;
    __device__ __forceinline__ const char* a_ptr(const Unit&) const { return (const char*)A; }
    __device__ __forceinline__ const char* b_ptr(const Unit& u) const { return (const char*)Bt + ((size_t)u.e * 2048 + (size_t)u.pn * 256) * (KD * ELT); }
    __device__ __forceinline__ const int* list_ptr(const Unit& u) const { return list + 2 * ((size_t)u.e * LIST_CAP + u.rt * 256); }
};
template <int ELT_> struct ProbDown {
    static constexpr bool GATHER = (ELT_ == 1), SWZ8 = (ELT_ == 1), CLAMP = false; static constexpr int ELT = ELT_;
    const void* A; const void* Bt; const int* ident;
    __device__ __forceinline__ const char* a_ptr(const Unit& u) const { return GATHER ? (const char*)A : (const char*)A + (size_t)u.pm * (256 * KD * ELT); }
    __device__ __forceinline__ const char* b_ptr(const Unit& u) const { return (const char*)Bt + ((size_t)u.e * 1024 + (size_t)u.pn * 256) * (KD * ELT); }
    __device__ __forceinline__ const int* list_ptr(const Unit& u) const { return ident + 2 * ((size_t)u.pm * 256); }
};

struct EpiBf16 {
    static constexpr bool PERM = true;
    bf16_t* O; int ldc; float sc;
    __device__ __forceinline__ void operator()(const f32x4 (&acc)[2][2][4][2], const Unit& u, int wr, int wc, int fr, int fq) const {
        const int row0 = u.pm * BM + wr * 64 + fr, col0 = u.pn * BM + wc * 32 + 8 * fq;
#pragma unroll
        for (int ai = 0; ai < 2; ++ai)
#pragma unroll
            for (int m = 0; m < 4; ++m) { bf16_t* rowp = O + (size_t)(row0 + ai * HALF + m * 16) * ldc + col0;
#pragma unroll
                for (int bj = 0; bj < 2; ++bj) { const f32x4 v0 = acc[ai][bj][m][0] * sc, v1 = acc[ai][bj][m][1] * sc;
                    u32x4 w; w.x = pk2(v0[0], v0[1]); w.y = pk2(v0[2], v0[3]); w.z = pk2(v1[0], v1[1]); w.w = pk2(v1[2], v1[3]);
                    *(u32x4*)(rowp + bj * HALF) = w; } }
    }
};
struct EpiF32 {
    static constexpr bool PERM = false;
    float* C; int ldc;
    __device__ __forceinline__ void operator()(const f32x4 (&acc)[2][2][4][2], const Unit& u, int wr, int wc, int fr, int fq) const {
        const int row0 = u.pm * BM + wr * 64 + fr, col0 = u.pn * BM + wc * 32 + 4 * fq;
#pragma unroll
        for (int ai = 0; ai < 2; ++ai)
#pragma unroll
            for (int m = 0; m < 4; ++m) { float* rowp = C + (size_t)(row0 + ai * HALF + m * 16) * ldc + col0;
#pragma unroll
                for (int bj = 0; bj < 2; ++bj)
#pragma unroll
                    for (int n = 0; n < 2; ++n) *(f32x4*)(rowp + bj * HALF + n * 16) = acc[ai][bj][m][n]; }
    }
};
template <bool F8> struct EpiGU {
    static constexpr bool PERM = true;
    void* act; const float* b_gu;
    __device__ __forceinline__ void operator()(const f32x4 (&acc)[2][2][4][2], const Unit& u, int wr, int wc, int fr, int fq) const {
        const int row0 = u.pm * BM + wr * 64 + fr, col0 = u.pn * 128 + wc * 32 + 8 * fq;
        const float* bg = b_gu + (size_t)u.e * 2048 + col0;
        const f32x4 bg0 = *(const f32x4*)(bg), bg1 = *(const f32x4*)(bg + 4), bl0 = *(const f32x4*)(bg + 1024), bl1 = *(const f32x4*)(bg + 1028);
        __builtin_amdgcn_s_waitcnt(0x0F70);
        const float sc = F8 ? 1.f / (F8_SA * F8_SW) : 1.f;
        const f32x4 bl0p = bl0 + 1.0f, bl1p = bl1 + 1.0f;
        constexpr float CE = -1.702f * 1.4426950408889634f;
#pragma unroll
        for (int ai = 0; ai < 2; ++ai)
#pragma unroll
            for (int m = 0; m < 4; ++m) {
                float r[8];
#pragma unroll
                for (int n = 0; n < 2; ++n)
#pragma unroll
                    for (int j = 0; j < 4; ++j) {
                        float g = __builtin_fmaf(acc[ai][0][m][n][j], sc, (n ? bg1[j] : bg0[j])); float l1 = __builtin_fmaf(acc[ai][1][m][n][j], sc, (n ? bl1p[j] : bl0p[j]));
                        g = fminf(g, 7.0f); l1 = __builtin_amdgcn_fmed3f(l1, -6.0f, 8.0f);
                        const float t = __builtin_amdgcn_exp2f(F8 ? __builtin_fmaf(g, CE, -2.0f) : g * CE);
                        r[n * 4 + j] = (g * __builtin_amdgcn_rcpf((F8 ? 0.25f : 1.0f) + t)) * l1; }
                if (F8) { u32x2 w; w.x = pk4_fp8_nc(r[0], r[1], r[2], r[3]); w.y = pk4_fp8_nc(r[4], r[5], r[6], r[7]);
                    *(u32x2*)((unsigned char*)act + (size_t)(row0 + ai * HALF + m * 16) * 1024 + col0) = w; }
                else { u32x4 w; w.x = pk2(r[0], r[1]); w.y = pk2(r[2], r[3]); w.z = pk2(r[4], r[5]); w.w = pk2(r[6], r[7]);
                    *(u32x4*)((bf16_t*)act + (size_t)(row0 + ai * HALF + m * 16) * 1024 + col0) = w; } }
    }
};
template <bool F8> struct EpiDown {
    static constexpr bool PERM = true;
    bf16_t* ypair; const float* b_down; const int* list;
    __device__ __forceinline__ void operator()(const f32x4 (&acc)[2][2][4][2], const Unit& u, int wr, int wc, int fr, int fq) const {
        const int col0 = u.pn * BM + wc * 32 + 8 * fq;
        const float* bd = b_down + (size_t)u.e * 1024 + col0;
        f32x4 bv[2][2];
#pragma unroll
        for (int bj = 0; bj < 2; ++bj)
#pragma unroll
            for (int n = 0; n < 2; ++n) bv[bj][n] = *(const f32x4*)(bd + bj * HALF + 4 * n);
        const u32x2* lp = (const u32x2*)list + (size_t)u.e * LIST_CAP + u.rt * 256;
        int pr[2][4]; float gt[2][4];
#pragma unroll
        for (int ai = 0; ai < 2; ++ai)
#pragma unroll
            for (int m = 0; m < 4; ++m) { const int r = ai * HALF + wr * 64 + m * 16 + fr; const bool ok = r < u.nvalid; const u32x2 en = lp[ok ? r : 0]; pr[ai][m] = ok ? (int)en.x : -1; gt[ai][m] = __uint_as_float(en.y); }
        __builtin_amdgcn_s_waitcnt(0x0F70);
#pragma unroll
        for (int ai = 0; ai < 2; ++ai)
#pragma unroll
            for (int m = 0; m < 4; ++m) {
                if (pr[ai][m] >= 0) {
                    bf16_t* rowp = ypair + (size_t)pr[ai][m] * 1024 + col0; const float g = gt[ai][m]; const float sc = F8 ? 1.f / (F8_SACT * F8_SW) : 1.f;
#pragma unroll
                    for (int bj = 0; bj < 2; ++bj) { const f32x4 v0 = (acc[ai][bj][m][0] * sc + bv[bj][0]) * g, v1 = (acc[ai][bj][m][1] * sc + bv[bj][1]) * g;
                        u32x4 w; w.x = pk2(v0[0], v0[1]); w.y = pk2(v0[2], v0[3]); w.z = pk2(v1[0], v1[1]); w.w = pk2(v1[2], v1[3]);
                        *(u32x4*)(rowp + bj * HALF) = w; }
                }
            }
    }
};

template <class Epi, class Sched, class Prob>
__device__ __forceinline__ void gemm_phase(LAS unsigned char* lds, const Prob& P, const Sched& S, const Epi& E) {
    const int tid = threadIdx.x, wid = __builtin_amdgcn_readfirstlane(tid >> 6), lane = tid & 63, wr = wid >> 2, wc = wid & 3, fr = lane & 15, fq = lane >> 4;
    constexpr int ELT = Prob::ELT, K = KD * ELT / 2  , nt = (KD * ELT) / (BK * 2);
    unsigned voffA, voffB;
#define PG8_MKOFF(T) do { int R, C; stage_rc((T) * 16, R, C); const int Rb = Epi::PERM ? ((R & ~31) + perm32(R & 31)) : R; voffA = (unsigned)(R * K + C) * 2u; voffB = (unsigned)(Rb * K + C) * 2u; } while (0)
    PG8_MKOFF(tid);
    constexpr unsigned istep = 64u * (unsigned)K * 2u;
    unsigned voffG[2][2] = {{0u, 0u}, {0u, 0u}};
    LAS int* idxbuf = (LAS int*)(lds + IDXBUF_OFF);
    const size_t kstep = (size_t)(BK * 2);
    const size_t hstep = (size_t)HALF * K * 2;
    const unsigned ldsw = (unsigned)wid * 1024u;
    const int sw8 = Prob::SWZ8 ? 16 * (fq & 1) : 0;
    const int aoff = lds_byte(wr * 64 + fr, fq * 8 * (3 - ELT)), boff = lds_byte(wc * 32 + fr, fq * 8 * (3 - ELT));
#define PG8_SA(b, h) (((b) * 2 + (h)) * HTB)
#define PG8_SB(b, h) ((4 + (b) * 2 + (h)) * HTB)
#define PG8_STAGE(bufoff, gbase, voff) do { _Pragma("unroll") for (int _i = 0; _i < 2; ++_i) \
        __builtin_amdgcn_global_load_lds((const unsigned*)((const char*)(gbase) + _i * istep + (voff)), (LAS unsigned*)(lds + (bufoff) + ldsw + _i * 8192), 16, 0, 0); } while (0)
#define PG8_GSTAGE(bufoff, gbase, voff) do { _Pragma("unroll") for (int _i = 0; _i < 2; ++_i) \
        __builtin_amdgcn_global_load_lds((const unsigned*)((const char*)(gbase) + (voff)[_i]), (LAS unsigned*)(lds + (bufoff) + ldsw + _i * 8192), 16, 0, 0); } while (0)
#define PG8_ASTAGE(bufoff, gbase, h) do { if constexpr (Prob::GATHER) { PG8_GSTAGE(bufoff, gbase, voffG[h]); } else { PG8_STAGE(bufoff, (gbase) + (h) * hstep, voffA); } } while (0)
#define PG8_LD8(addr) __builtin_shufflevector(*(const LAS u32x4*)((addr) + sw8), *(const LAS u32x4*)((addr) + 16 - sw8), 0, 1, 2, 3, 4, 5, 6, 7)
#define PG8_LDA(dst, b, h) do { if constexpr (ELT == 2) { _Pragma("unroll") for (int m = 0; m < 4; ++m) _Pragma("unroll") for (int k = 0; k < 2; ++k) dst[m][k] = *(const LAS u32x4*)(lds + PG8_SA(b, h) + aoff + m * 2048 + k * 1024); } \
        else { _Pragma("unroll") for (int m = 0; m < 4; ++m) dst##8[m] = PG8_LD8(lds + PG8_SA(b, h) + aoff + m * 2048); } } while (0)
#define PG8_LDB(dst, b, h) do { if constexpr (ELT == 2) { _Pragma("unroll") for (int n = 0; n < 2; ++n) _Pragma("unroll") for (int k = 0; k < 2; ++k) dst[n][k] = *(const LAS u32x4*)(lds + PG8_SB(b, h) + boff + n * 2048 + k * 1024); } \
        else { _Pragma("unroll") for (int n = 0; n < 2; ++n) dst##8[n] = PG8_LD8(lds + PG8_SB(b, h) + boff + n * 2048); } } while (0)
#define PG8_MMA(ai, bj, At, Bt) do { __builtin_amdgcn_s_setprio(1); if constexpr (ELT == 2) { _Pragma("unroll") for (int m = 0; m < 4; ++m) _Pragma("unroll") for (int n = 0; n < 2; ++n) _Pragma("unroll") for (int k = 0; k < 2; ++k) \
        acc[ai][bj][m][n] = __builtin_amdgcn_mfma_f32_16x16x32_bf16(__builtin_bit_cast(bf16x8, Bt[n][k]), __builtin_bit_cast(bf16x8, At[m][k]), acc[ai][bj][m][n], 0, 0, 0); } \
        else { _Pragma("unroll") for (int m = 0; m < 4; ++m) _Pragma("unroll") for (int n = 0; n < 2; ++n) \
        acc[ai][bj][m][n] = __builtin_amdgcn_mfma_scale_f32_16x16x128_f8f6f4(__builtin_bit_cast(v8i32, Bt##8[n]), __builtin_bit_cast(v8i32, At##8[m]), acc[ai][bj][m][n], 0, 0, 0, 0x7F7F7F7F, 0, 0x7F7F7F7F); } \
        __builtin_amdgcn_s_setprio(0); } while (0)
#define PG8_WAIT_V(n) asm volatile("s_waitcnt vmcnt(" #n ")" ::: "memory")
#define PG8_WAIT_L(n) asm volatile("s_waitcnt lgkmcnt(" #n ")" ::: "memory")
#define PG8_BAR __builtin_amdgcn_s_barrier()
#define PG8_SCHED __builtin_amdgcn_sched_barrier(0)
    Unit cur, nxt; int ui = 0;
    if (!S.next(0, cur)) return;
    f32x4 acc[2][2][4][2];
#pragma unroll
    for (int a = 0; a < 2; ++a)
#pragma unroll
        for (int b = 0; b < 2; ++b)
#pragma unroll
            for (int m = 0; m < 4; ++m)
#pragma unroll
                for (int n = 0; n < 2; ++n) acc[a][b][m][n] = (f32x4){0.f, 0.f, 0.f, 0.f};
    u32x4 At[4][2], B0[2][2], B1[2][2];
    u32x8 At8[4], B08[2], B18[2];
    const char* cA = P.a_ptr(cur); const char* cB = P.b_ptr(cur);
    if constexpr (Prob::GATHER) {
        const int* lp = P.list_ptr(cur); const int R0 = (wid >> 1) * 16 + (lane >> 2); const unsigned coff = (unsigned)((wid & 1) * 32 + (((lane & 3) * 8) ^ ((lane >> 5) << 4))) * 2u;
#pragma unroll
        for (int h = 0; h < 2; ++h)
#pragma unroll
            for (int i = 0; i < 2; ++i) { const int row = h * 128 + R0 + 64 * i; const int pair = (!Prob::CLAMP || row < cur.nvalid) ? lp[2 * row] : 0; voffG[h][i] = (unsigned)(pair >> 2) * (unsigned)(KD * ELT) + coff; }
        Unit u1; if (S.next(1, u1) && tid < 256) idxbuf[256 + tid] = P.list_ptr(u1)[2 * tid];
    }
    PG8_STAGE(PG8_SB(0, 0), cB, voffB); PG8_STAGE(PG8_SB(0, 1), cB + hstep, voffB); PG8_ASTAGE(PG8_SA(0, 0), cA, 0); PG8_ASTAGE(PG8_SA(0, 1), cA, 1);
    if (wr == 1) PG8_BAR;
    PG8_WAIT_V(2); PG8_BAR;
    PG8_STAGE(PG8_SB(1, 0), cB + kstep, voffB); PG8_ASTAGE(PG8_SA(1, 0), cA + kstep, 0); PG8_STAGE(PG8_SB(1, 1), cB + hstep + kstep, voffB);
    PG8_WAIT_V(6); PG8_BAR;
    for (;;) {
        const bool has_next = S.next(ui + 1, nxt);
        const char* nA = has_next ? P.a_ptr(nxt) : cA; const char* nB = has_next ? P.b_ptr(nxt) : cB;
#pragma unroll 1
        for (int t = 0; t < nt; t += 2) {
            const bool last = (t == nt - 2);
            const char* a1 = cA + (size_t)(t + 1) * kstep;
            const char* a2 = last ? nA : cA + (size_t)(t + 2) * kstep; const char* b2 = last ? nB : cB + (size_t)(t + 2) * kstep;
            const char* a3 = a2 + kstep; const char* b3 = b2 + kstep;
            { int tz = threadIdx.x; asm volatile("" : "+v"(tz)); PG8_MKOFF(tz); }
            PG8_LDB(B0, 0, 0); PG8_LDB(B1, 0, 1); PG8_SCHED; PG8_LDA(At, 0, 0); PG8_ASTAGE(PG8_SA(1, 1), a1, 1);
            if constexpr (Prob::GATHER) { if (last && has_next) {
                const int R0 = (wid >> 1) * 16 + (lane >> 2); const unsigned coff = (unsigned)((wid & 1) * 32 + (((lane & 3) * 8) ^ ((lane >> 5) << 4))) * 2u; const LAS int* ib = idxbuf + ((ui + 1) & 1) * 256;
#pragma unroll
                for (int h = 0; h < 2; ++h)
#pragma unroll
                    for (int i = 0; i < 2; ++i) { const int row = h * 128 + R0 + 64 * i; const int pair = (!Prob::CLAMP || row < nxt.nvalid) ? ib[row] : 0; voffG[h][i] = (unsigned)(pair >> 2) * (unsigned)(KD * ELT) + coff; } } }
            PG8_WAIT_V(8); PG8_WAIT_L(0); PG8_BAR; PG8_MMA(0, 0, At, B0); PG8_MMA(0, 1, At, B1); PG8_BAR; PG8_SCHED;
            PG8_LDA(At, 0, 1); PG8_STAGE(PG8_SB(0, 0), b2, voffB); PG8_STAGE(PG8_SB(0, 1), b2 + hstep, voffB); PG8_ASTAGE(PG8_SA(0, 0), a2, 0);
            PG8_WAIT_V(8); PG8_WAIT_L(0); PG8_BAR; PG8_MMA(1, 0, At, B0); PG8_MMA(1, 1, At, B1); PG8_BAR; PG8_SCHED;
            PG8_LDB(B0, 1, 0); PG8_LDB(B1, 1, 1); PG8_SCHED; PG8_LDA(At, 1, 0); PG8_ASTAGE(PG8_SA(0, 1), a2, 1);
            PG8_WAIT_V(8); PG8_WAIT_L(0); PG8_BAR; PG8_MMA(0, 0, At, B0); PG8_MMA(0, 1, At, B1); PG8_BAR; PG8_SCHED;
            PG8_LDA(At, 1, 1); PG8_STAGE(PG8_SB(1, 0), b3, voffB); PG8_STAGE(PG8_SB(1, 1), b3 + hstep, voffB); PG8_ASTAGE(PG8_SA(1, 0), a3, 0);
            PG8_WAIT_V(8); PG8_WAIT_L(0); PG8_BAR; PG8_MMA(1, 0, At, B0); PG8_MMA(1, 1, At, B1); PG8_BAR; PG8_SCHED;
        }
        if (wr == 0) PG8_BAR;
        int nidx = 0; bool have2 = false;
        if constexpr (Prob::GATHER) { Unit u2; have2 = S.next(ui + 2, u2); if (have2 && tid < 256) nidx = P.list_ptr(u2)[2 * tid]; }
        { int tz = threadIdx.x; asm volatile("" : "+v"(tz));
          const int wz = tz >> 6, lz = tz & 63; E(acc, cur, wz >> 2, wz & 3, lz & 15, lz >> 4); }
        if constexpr (Prob::GATHER) { if (have2 && tid < 256) idxbuf[(ui & 1) * 256 + tid] = nidx; }
        if (!has_next) break;
#pragma unroll
        for (int a = 0; a < 2; ++a)
#pragma unroll
            for (int b = 0; b < 2; ++b)
#pragma unroll
                for (int m = 0; m < 4; ++m)
#pragma unroll
                    for (int n = 0; n < 2; ++n) acc[a][b][m][n] = (f32x4){0.f, 0.f, 0.f, 0.f};
        cur = nxt; cA = nA; cB = nB; ++ui;
        if (wr == 1) PG8_BAR;
    }
    PG8_WAIT_V(0);
    PG8_BAR;
#undef PG8_SA
#undef PG8_SB
#undef PG8_STAGE
#undef PG8_GSTAGE
#undef PG8_MKOFF
#undef PG8_ASTAGE
#undef PG8_LDA
#undef PG8_LDB
#undef PG8_MMA
#undef PG8_WAIT_V
#undef PG8_WAIT_L
#undef PG8_BAR
#undef PG8_SCHED
}
}

struct Args { const float* in[19]; float* out; unsigned char* ws; int ph_lo, ph_hi; };
typedef const Args __attribute__((address_space(4)))* CArgs;
struct Ctx {
    LAS unsigned char* lds; int tid, lane, wave, G, bid; CArgs ap; unsigned char* ws;
};
#define LDS_FENCE() asm volatile("s_waitcnt lgkmcnt(0)" ::: "memory")

template <bool F8> __device__ __forceinline__ void p0_transpose_item(const float* W, int N, int k0, int n0, void* dst_row0, LAS float* scr, int lane) {
    const int q = lane & 15, kr = lane >> 4;
    f32x4 v[16];
#pragma unroll
    for (int i = 0; i < 16; ++i) v[i] = *(const f32x4*)(W + (size_t)(k0 + 4 * i + kr) * N + n0 + 4 * q);
#pragma unroll
    for (int i = 0; i < 16; ++i) { const int k = 4 * i + kr;
        scr[(4 * q + 0) * 65 + k] = v[i].x; scr[(4 * q + 1) * 65 + k] = v[i].y; scr[(4 * q + 2) * 65 + k] = v[i].z; scr[(4 * q + 3) * 65 + k] = v[i].w; }
    LDS_FENCE();
    if (F8) { const int c = lane & 3;
#pragma unroll
        for (int j = 0; j < 4; ++j) { const int n = (lane >> 2) + 16 * j; const LAS float* s = scr + n * 65 + 16 * c;
            u32x4 o; o.x = pk4_fp8(s[0] * F8_SW, s[1] * F8_SW, s[2] * F8_SW, s[3] * F8_SW); o.y = pk4_fp8(s[4] * F8_SW, s[5] * F8_SW, s[6] * F8_SW, s[7] * F8_SW);
            o.z = pk4_fp8(s[8] * F8_SW, s[9] * F8_SW, s[10] * F8_SW, s[11] * F8_SW); o.w = pk4_fp8(s[12] * F8_SW, s[13] * F8_SW, s[14] * F8_SW, s[15] * F8_SW);
            *(u32x4*)((unsigned char*)dst_row0 + (size_t)n * 1024 + k0 + 16 * c) = o; }
    } else { const int c = lane & 7;
#pragma unroll
        for (int j = 0; j < 8; ++j) { const int n = (lane >> 3) + 8 * j; const LAS float* s = scr + n * 65 + 8 * c;
            u32x4 o; o.x = pk2(s[0], s[1]); o.y = pk2(s[2], s[3]); o.z = pk2(s[4], s[5]); o.w = pk2(s[6], s[7]);
            *(u32x4*)((bf16_t*)dst_row0 + (size_t)n * 1024 + k0 + 8 * c) = o; }
    }
    LDS_FENCE();
}
__device__ __forceinline__ void p0_prologue(Ctx& F) {
    {
        LAS float* cond = (LAS float*)F.lds; LAS float* red = cond + 4096;
        for (int i = F.tid; i < 4096; i += 512) { const float v = (F.ap->in[1])[i]; cond[i] = v * sigmoidf_(v); }
        __syncthreads();
        float* mod = (float*)(F.ws + WS_MOD);
        for (int u = F.bid; u < 192; u += F.G) {
            const int n0 = u * 32, q = F.tid & 7, kg = F.tid >> 3;
            f32x4 a0 = {0.f, 0.f, 0.f, 0.f}, a1 = a0, a2 = a0, a3 = a0;
#pragma unroll 4
            for (int i = 0; i < 16; ++i) { const int k = kg + 64 * i; const f32x4 w = *(const f32x4*)((F.ap->in[2]) + (size_t)k * 6144 + n0 + 4 * q);
                a0 += w * cond[k]; a1 += w * cond[1024 + k]; a2 += w * cond[2048 + k]; a3 += w * cond[3072 + k]; }
            *(LAS f32x4*)(red + kg * 128 + 0 + 4 * q) = a0; *(LAS f32x4*)(red + kg * 128 + 32 + 4 * q) = a1;
            *(LAS f32x4*)(red + kg * 128 + 64 + 4 * q) = a2; *(LAS f32x4*)(red + kg * 128 + 96 + 4 * q) = a3;
            __syncthreads();
            if (F.tid < 128) { float s = 0.f;
                for (int g = 0; g < 64; ++g) s += red[g * 128 + F.tid];
                const int b = F.tid >> 5, col = F.tid & 31; mod[b * 6144 + n0 + col] = s + (F.ap->in[3])[n0 + col]; }
            __syncthreads();
        }
        __syncthreads();
    }
    for (int idx = F.bid * 512 + F.tid; idx < 32768; idx += F.G * 512) { const int k = idx >> 5, e = idx & 31; const float w = (F.ap->in[13])[idx];
        const unsigned hi = pk2(w, 0.f) & 0xffffu; const unsigned lo = pk2(w - bf2f(hi), 0.f) & 0xffffu;
        bf16_t* wrt = (bf16_t*)(F.ws + WS_WRT); wrt[e * 1024 + k] = (bf16_t)hi; wrt[32768 + e * 1024 + k] = (bf16_t)lo; }
    for (int idx = F.bid * 512 + F.tid; idx < ACT_ROWS; idx += F.G * 512) ((u32x2*)(F.ws + WS_IDENT))[idx] = (u32x2){(unsigned)(4 * idx), 0u};
    LAS float* scr = (LAS float*)F.lds + F.wave * 4160;
    const int gw = F.bid * 8 + F.wave, NGW = F.G * 8;
    constexpr int I_GU = 32 * 16 * 32, I_DN = 32 * 16 * 16, I_IN = 16 * 56, I_OUT = 16 * 16, NITEMS = I_IN + I_OUT + I_GU + I_DN;
    for (int it = gw; it < NITEMS; it += NGW) {
        int r = it;
        if (r < I_GU) { const int e = r / 512, r2 = r % 512, kb = r2 / 32, nb = r2 % 32; const int n0 = nb * 64;
            const int drow = (n0 < 1024) ? ((n0 >> 7) * 256 + (n0 & 127)) : (((n0 - 1024) >> 7) * 256 + 128 + ((n0 - 1024) & 127));
            p0_transpose_item<MOE_FP8 != 0>((F.ap->in[15]) + (size_t)e * 1024 * 2048, 2048, kb * 64, n0, (unsigned char*)(F.ws + WS_WGU) + ((size_t)e * 2048 + drow) * (MOE_FP8 ? 1024 : 2048), scr, F.lane);
            continue; } r -= I_GU;
        if (r < I_DN) { const int e = r / 256, r2 = r % 256, kb = r2 / 16, nb = r2 % 16;
            p0_transpose_item<MOE_FP8 != 0>((F.ap->in[17]) + (size_t)e * 1024 * 1024, 1024, kb * 64, nb * 64, (unsigned char*)(F.ws + WS_WDN) + ((size_t)e * 1024 + nb * 64) * (MOE_FP8 ? 1024 : 2048), scr, F.lane);
            continue; } r -= I_DN;
        if (r < I_IN) { const int kb = r / 56, nb = r % 56; p0_transpose_item<G1_FP8 != 0>((F.ap->in[6]), DIN, kb * 64, nb * 64, (unsigned char*)(F.ws + WS_WIN) + (size_t)(nb * 64) * (G1_FP8 ? 1024 : 2048), scr, F.lane); continue; } r -= I_IN;
        { const int kb = r / 16, nb = r % 16; p0_transpose_item<false>((F.ap->in[10]), D, kb * 64, nb * 64, (bf16_t*)(F.ws + WS_WOUT) + (size_t)(nb * 64) * 1024, scr, F.lane); }
    }
}

__device__ __forceinline__ void p1_norm_mod(Ctx& F) {
    const int gw = F.bid * 8 + F.wave, NGW = F.G * 8;
    const float* mod = (const float*)(F.ws + WS_MOD); const float* xin = (F.ap->in[0]); const float* gpm = (F.ap->in[4]);
    bf16_t* H = (bf16_t*)(F.ws + WS_H);
    f32x4 g[4], sh[4], sc[4]; int bcur = -1;
#pragma unroll
    for (int j = 0; j < 4; ++j) g[j] = *(const f32x4*)(gpm + 4 * F.lane + 256 * j);
    f32x4 n0[4], n1[4];
    if (gw < T) {
#pragma unroll
        for (int j = 0; j < 4; ++j) n0[j] = ((const f32x4*)(xin + (size_t)gw * D) + F.lane)[64 * j]; }
    if (gw + NGW < T) {
#pragma unroll
        for (int j = 0; j < 4; ++j) n1[j] = ((const f32x4*)(xin + (size_t)(gw + NGW) * D) + F.lane)[64 * j]; }
    for (int m = gw; m < T; m += NGW) {
        const int b = m / SEQ;
        if (b != bcur) { bcur = b;
#pragma unroll
            for (int j = 0; j < 4; ++j) { const int k = 4 * F.lane + 256 * j; sh[j] = *(const f32x4*)(mod + b * 6144 + k); sc[j] = *(const f32x4*)(mod + b * 6144 + 1024 + k) + 1.0f; } }
        f32x4 v[4]; float ss = 0.f;
#pragma unroll
        for (int j = 0; j < 4; ++j) { v[j] = n0[j]; n0[j] = n1[j]; ss += (v[j].x * v[j].x + v[j].y * v[j].y) + (v[j].z * v[j].z + v[j].w * v[j].w); }
        if (m + 2 * NGW < T) {
#pragma unroll
            for (int j = 0; j < 4; ++j) n1[j] = ((const f32x4*)(xin + (size_t)(m + 2 * NGW) * D) + F.lane)[64 * j]; }
        const float rstd = 1.0f / sqrtf(wave_sum(ss) * (1.f / D) + EPS);
        u32x2* o = (u32x2*)(H + (size_t)m * D) + F.lane;
#pragma unroll
        for (int j = 0; j < 4; ++j) {
            const f32x4 h = v[j] * rstd * g[j] * sc[j] + sh[j];
            if (G1_FP8) ((unsigned*)((unsigned char*)(F.ws + WS_H) + (size_t)m * D) + F.lane)[64 * j] = pk4_fp8(h.x * F8_SA, h.y * F8_SA, h.z * F8_SA, h.w * F8_SA);
            else { u32x2 w; w.x = pk2(h.x, h.y); w.y = pk2(h.z, h.w); o[64 * j] = w; } }
    }
}

constexpr int HG_QE = 0, HG_KE = 8704, HG_KD = 17408, HG_V = 27648, HG_SEG = 37888, HG_DEC = 41984, HG_OP = 42496;
__device__ __forceinline__ void hgrn_local_unit(Ctx& F, int u) {
    const int bh = u >> 4, jj = u & 15, b = bh >> 2, h = bh & 3;
    const int rowbase = b * SEQ + jj * 256;
    const bf16_t* proj = (const bf16_t*)(F.ws + WS_PROJ);
    bf16_t* QE = (bf16_t*)(F.ws + WS_QE); bf16_t* OLOC = (bf16_t*)(F.ws + WS_OLOC);
    LAS unsigned char* L = F.lds;
    const int seg = F.wave, dp = F.lane;
    const int eb = F.wave & 3, dh = F.wave >> 2, c32 = F.lane & 31, hh = F.lane >> 5;
    const int i16 = F.lane & 15, tq = i16 >> 2, tp = i16 & 3, blk = (F.lane >> 4) & 1;
    float lbv[2], oml[2], ecum[2] = {1.f, 1.f};
#pragma unroll
    for (int dd = 0; dd < 2; ++dd) { const int d = h * 128 + 2 * dp + dd; const float a0 = (F.ap->in[8])[d], a1 = (F.ap->in[8])[512 + d]; lbv[dd] = 1.f / (1.f + __expf(a1 - a0)); oml[dd] = 1.f - lbv[dd]; }
    f32x16 Sacc[2];
#pragma unroll
    for (int i = 0; i < 2; ++i)
#pragma unroll
        for (int r = 0; r < 16; ++r) Sacc[i][r] = 0.f;
    LAS float* segtot = (LAS float*)(L + HG_SEG); LAS float* dec = (LAS float*)(L + HG_DEC); LAS float* op = (LAS float*)(L + HG_OP);
    unsigned nfr[4], nqr[4], nv2[4];
#pragma unroll
    for (int i = 0; i < 4; ++i) { const bf16_t* rp = proj + (size_t)(rowbase + 4 * seg + i) * DIN + h * 128 + 2 * dp;
        nfr[i] = *(const unsigned*)(rp + C_FR); nqr[i] = *(const unsigned*)(rp + C_QR); nv2[i] = *(const unsigned*)(rp + C_IR); }
    for (int sc = 0; sc < 8; ++sc) {
        const int row0 = rowbase + sc * 32;
        unsigned fr2[4], qr2[4], v2[4];
#pragma unroll
        for (int i = 0; i < 4; ++i) { fr2[i] = nfr[i]; qr2[i] = nqr[i]; v2[i] = nv2[i]; }
        if (sc < 7) {
#pragma unroll
            for (int i = 0; i < 4; ++i) { const bf16_t* rp = proj + (size_t)(row0 + 32 + 4 * seg + i) * DIN + h * 128 + 2 * dp;
                nfr[i] = *(const unsigned*)(rp + C_FR); nqr[i] = *(const unsigned*)(rp + C_QR); nv2[i] = *(const unsigned*)(rp + C_IR); } }
        float Pc[4][2], kk[4][2], qq[4][2], run[2] = {1.f, 1.f};
#pragma unroll
        for (int i = 0; i < 4; ++i)
#pragma unroll
            for (int dd = 0; dd < 2; ++dd) {
                const float fr = dd ? bfhi(fr2[i]) : bflo(fr2[i]); const float qr = dd ? bfhi(qr2[i]) : bflo(qr2[i]);
                const float sg = sigmoidf_(fr); const float f = lbv[dd] + oml[dd] * sg;
                kk[i][dd] = oml[dd] * (1.f - sg); run[dd] *= f; Pc[i][dd] = run[dd]; qq[i][dd] = qr * sigmoidf_(qr); }
        *(LAS f32x2*)(segtot + seg * 128 + 2 * dp) = (f32x2){run[0], run[1]};
        __syncthreads();
        float pre[2] = {1.f, 1.f}, tot[2] = {1.f, 1.f};
#pragma unroll
        for (int s = 0; s < 8; ++s) { const f32x2 t2 = *(const LAS f32x2*)(segtot + s * 128 + 2 * dp);
            pre[0] *= (s < seg) ? t2.x : 1.f; pre[1] *= (s < seg) ? t2.y : 1.f; tot[0] *= t2.x; tot[1] *= t2.y; }
#pragma unroll
        for (int i = 0; i < 4; ++i) { const int trow = 4 * seg + i; float qe[2], ke[2], kd[2];
#pragma unroll
            for (int dd = 0; dd < 2; ++dd) { const float Eb = pre[dd] * Pc[i][dd]; const float inv = 1.f / Eb; qe[dd] = qq[i][dd] * Eb; ke[dd] = kk[i][dd] * inv; kd[dd] = ke[dd] * tot[dd]; }
            *(LAS unsigned*)(L + HG_QE + trow * 272 + 4 * dp) = pk2(qe[0], qe[1]);
            *(LAS unsigned*)(L + HG_KE + trow * 272 + 4 * dp) = pk2(ke[0], ke[1]);
            *(LAS unsigned*)(L + HG_KD + trow * 320 + 4 * dp) = pk2(kd[0], kd[1]);
            *(LAS unsigned*)(L + HG_V + trow * 320 + 4 * dp) = v2[i];
            *(unsigned*)(QE + (size_t)(row0 + trow) * 512 + h * 128 + 2 * dp) = pk2(qe[0] * ecum[0], qe[1] * ecum[1]); }
        if (seg == 0) *(LAS f32x2*)(dec + 2 * dp) = (f32x2){tot[0], tot[1]};
        ecum[0] *= tot[0]; ecum[1] *= tot[1];
        __syncthreads();
        f32x16 X;
#pragma unroll
        for (int r = 0; r < 16; ++r) X[r] = 0.f;
#pragma unroll
        for (int k = 0; k < 4; ++k) { const int dofs = (64 * dh + 16 * k + 8 * hh) * 2;
            const bf16x8 a = *(const LAS bf16x8*)(L + HG_KE + c32 * 272 + dofs); const bf16x8 bq = *(const LAS bf16x8*)(L + HG_QE + c32 * 272 + dofs);
            X = MFMA32(a, bq, X); }
#pragma unroll
        for (int r = 0; r < 16; ++r) X[r] = (crow(r, hh) <= c32) ? X[r] : 0.f;
        f32x16 O;
#pragma unroll
        for (int r = 0; r < 16; ++r) O[r] = 0.f;
#pragma unroll
        for (int s2 = 0; s2 < 2; ++s2) { const LAS unsigned char* vb = L + HG_V + (16 * s2 + 4 * hh + tq) * 320 + (32 * eb + 16 * blk + 4 * tp) * 2;
            const bf16x8 a2 = cat8(tr_read(vb), tr_read(vb + 8 * 320)); O = MFMA32(a2, pack_step(X, s2), O); }
#pragma unroll
        for (int i = 0; i < 2; ++i)
#pragma unroll
            for (int s3 = 0; s3 < 2; ++s3) { const LAS unsigned char* qb = L + HG_QE + c32 * 272 + (32 * (2 * dh + i) + 16 * s3 + 4 * hh) * 2;
                const s16x4 lo = *(const LAS s16x4*)qb, hi = *(const LAS s16x4*)(qb + 16);
                O = MFMA32(pack_step(Sacc[i], s3), cat8(lo, hi), O); }
#pragma unroll
        for (int i = 0; i < 2; ++i) { const int dblk = 2 * dh + i;
#pragma unroll
            for (int r = 0; r < 16; ++r) Sacc[i][r] *= dec[32 * dblk + crow(r, hh)];
#pragma unroll
            for (int st = 0; st < 2; ++st) { const LAS unsigned char* ka = L + HG_KD + (16 * st + 8 * hh + tq) * 320 + (32 * dblk + 16 * blk + 4 * tp) * 2;
                const LAS unsigned char* va = L + HG_V + (16 * st + 8 * hh + tq) * 320 + (32 * eb + 16 * blk + 4 * tp) * 2;
                const bf16x8 a4 = cat8(tr_read(ka), tr_read(ka + 4 * 320)); const bf16x8 b4 = cat8(tr_read(va), tr_read(va + 4 * 320));
                Sacc[i] = MFMA32(a4, b4, Sacc[i]); } }
        if (dh == 1) {
#pragma unroll
            for (int r = 0; r < 16; ++r) op[(eb * 16 + r) * 64 + F.lane] = O[r]; }
        __syncthreads();
        if (dh == 0) {
#pragma unroll
            for (int r = 0; r < 16; ++r) O[r] += op[(eb * 16 + r) * 64 + F.lane];
            bf16_t* orow = OLOC + (size_t)(row0 + c32) * 512 + h * 128 + 32 * eb + 4 * hh;
#pragma unroll
            for (int g = 0; g < 4; ++g) { u32x2 w; w.x = pk2(O[4 * g], O[4 * g + 1]); w.y = pk2(O[4 * g + 2], O[4 * g + 3]); *(u32x2*)(orow + 8 * g) = w; } }
    }
    float* SL = (float*)(F.ws + WS_SLOC) + (size_t)u * 16384;
#pragma unroll
    for (int i = 0; i < 2; ++i)
#pragma unroll
        for (int r = 0; r < 16; ++r) SL[(32 * (2 * dh + i) + crow(r, hh)) * 128 + 32 * eb + c32] = Sacc[i][r];
    if (seg == 0) *(f32x2*)((float*)(F.ws + WS_DTOT) + u * 128 + 2 * dp) = (f32x2){ecum[0], ecum[1]};
    __syncthreads();
}

constexpr int AT_KS = 144, AT_VS = 192, AT_K = 0, AT_V = 384 * 144;
struct AttnU { int n, dil, r, p, b, h; };
__device__ __forceinline__ AttnU attn_decode(int u) {
    AttnU a; a.n = u >> 9; const int rem = u & 511, bh = rem >> 4;
    if (a.n == 0) { a.dil = 1; a.p = rem & 15; a.r = 0; } else if (a.n == 1) { a.dil = 4; a.r = (rem >> 2) & 3; a.p = rem & 3; } else { a.dil = 16; a.r = rem & 15; a.p = 0; }
    a.b = bh >> 3; a.h = bh & 7; return a;
}
__device__ __forceinline__ void attn_load(Ctx& F, const AttnU& a, u32x4 (&kv)[12], bf16x8 (&qf)[4]) {
    const bf16_t* proj = (const bf16_t*)(F.ws + WS_PROJ);
#pragma unroll
    for (int it = 0; it < 12; ++it) { const int idx = F.tid + 512 * (it % 6); const int row = idx >> 3, pc = idx & 7; const int sub = 256 * a.p - 128 + row;
        const int subc = sub < 0 ? 0 : sub;
        const bf16_t* src = proj + (size_t)(a.b * SEQ + subc * a.dil + a.r) * DIN + (it < 6 ? C_KA : C_VA) + a.h * 64 + pc * 8;
        kv[it] = *(const u32x4*)src; }
    const int qsub = 256 * a.p + 32 * F.wave + (F.lane & 31); const size_t grow = (size_t)a.b * SEQ + (size_t)qsub * a.dil + a.r;
#pragma unroll
    for (int k = 0; k < 4; ++k) qf[k] = *(const bf16x8*)(proj + grow * DIN + C_QA + a.h * 64 + 16 * k + 8 * (F.lane >> 5));
}
__device__ __forceinline__ void attn_stage(Ctx& F, const AttnU& a, const u32x4 (&kv)[12]) {
    LAS unsigned char* L = F.lds;
#pragma unroll
    for (int it = 0; it < 12; ++it) { const int idx = F.tid + 512 * (it % 6); const int row = idx >> 3, pc = idx & 7; const int sub = 256 * a.p - 128 + row;
        const u32x4 v = (sub < 0) ? (u32x4){0u, 0u, 0u, 0u} : kv[it];
        if (it < 6) *(LAS u32x4*)(L + AT_K + row * AT_KS + pc * 16) = v; else *(LAS u32x4*)(L + AT_V + row * AT_VS + pc * 16) = v; }
}
__device__ __forceinline__ void attn_compute(Ctx& F, const AttnU& a, const bf16x8 (&qf)[4]) {
    LAS unsigned char* L = F.lds;
    const int w = F.wave, c32 = F.lane & 31, hh = F.lane >> 5;
    const int i16 = F.lane & 15, tq = i16 >> 2, tp = i16 & 3, blk = (F.lane >> 4) & 1;
    const int n = a.n, p = a.p, h = a.h;
    const int qsub = 256 * p + 32 * w + c32; const size_t grow = (size_t)a.b * SEQ + (size_t)qsub * a.dil + a.r;
    const int kb0 = (p == 0 && w < 4) ? (4 - w) : 0;
    f32x16 X[5];
#pragma unroll
    for (int kb = 0; kb < 5; ++kb) {
#pragma unroll
        for (int r16 = 0; r16 < 16; ++r16) X[kb][r16] = 0.f;
        if (kb >= kb0) {
#pragma unroll
            for (int k = 0; k < 4; ++k) { const bf16x8 af = *(const LAS bf16x8*)(L + AT_K + (32 * (w + kb) + c32) * AT_KS + (16 * k + 8 * hh) * 2); X[kb] = MFMA32(af, qf[k], X[kb]); } }
    }
    float m = -INFINITY;
#pragma unroll
    for (int kb = 0; kb < 5; ++kb)
#pragma unroll
        for (int r16 = 0; r16 < 16; ++r16) { const int row = crow(r16, hh);
            bool valid = (kb >= kb0); if (kb == 0) valid = valid && (row >= c32); if (kb == 4) valid = valid && (row <= c32);
            X[kb][r16] = valid ? X[kb][r16] : -INFINITY; m = fmaxf(m, X[kb][r16]); }
    m = fmaxf(m, __shfl_xor(m, 32));
    const float c2 = 0.125f * 1.4426950408889634f;
    float l = 0.f;
#pragma unroll
    for (int kb = 0; kb < 5; ++kb)
#pragma unroll
        for (int r16 = 0; r16 < 16; ++r16) { const float pv = __builtin_amdgcn_exp2f((X[kb][r16] - m) * c2); X[kb][r16] = pv; l += pv; }
    l += __shfl_xor(l, 32);
    f32x16 O[2];
#pragma unroll
    for (int i = 0; i < 2; ++i)
#pragma unroll
        for (int r16 = 0; r16 < 16; ++r16) O[i][r16] = 0.f;
#pragma unroll
    for (int kb = 0; kb < 5; ++kb) {
        if (kb >= kb0) {
#pragma unroll
            for (int s = 0; s < 2; ++s) { const bf16x8 pb = pack_step(X[kb], s);
#pragma unroll
                for (int dhf = 0; dhf < 2; ++dhf) { const LAS unsigned char* vb = L + AT_V + (32 * (w + kb) + 16 * s + 4 * hh + tq) * AT_VS + (32 * dhf + 16 * blk + 4 * tp) * 2;
                    const bf16x8 af = cat8(tr_read(vb), tr_read(vb + 8 * AT_VS)); O[dhf] = MFMA32(af, pb, O[dhf]); } } }
    }
    const float inv = rcpf_(l);
    bf16_t* po = (bf16_t*)(F.ws + WS_PARTO) + ((size_t)n * T + grow) * 512 + h * 64 + 4 * hh;
#pragma unroll
    for (int dhf = 0; dhf < 2; ++dhf)
#pragma unroll
        for (int g = 0; g < 4; ++g) { u32x2 wv; wv.x = pk2(O[dhf][4 * g] * inv, O[dhf][4 * g + 1] * inv); wv.y = pk2(O[dhf][4 * g + 2] * inv, O[dhf][4 * g + 3] * inv);
            *(u32x2*)(po + 32 * dhf + 8 * g) = wv; }
    if (hh == 0) ((float*)(F.ws + WS_LSE))[((size_t)n * T + grow) * 8 + h] = m * 0.125f + __logf(l);
}
__device__ __forceinline__ void attn_units(Ctx& F) {
    int u = F.bid; if (u >= 1536) return;
    u32x4 kv[12]; bf16x8 qf[4], qn[4];
    AttnU a = attn_decode(u);
    attn_load(F, a, kv, qn);
    for (; u < 1536; u += F.G) {
        attn_stage(F, a, kv);
#pragma unroll
        for (int k = 0; k < 4; ++k) qf[k] = qn[k];
        __syncthreads();
        const AttnU cur = a;
        if (u + F.G < 1536) { a = attn_decode(u + F.G); attn_load(F, a, kv, qn); }
        attn_compute(F, cur, qf);
        __syncthreads();
    }
}

__device__ __forceinline__ void p4_scan(Ctx& F) {
    const float* SL = (const float*)(F.ws + WS_SLOC); const float* DT = (const float*)(F.ws + WS_DTOT); bf16_t* SIN = (bf16_t*)(F.ws + WS_SIN);
    for (int unit = F.bid; unit < 256; unit += F.G) {
        const int bh = unit >> 4, bk = unit & 15, db = bk >> 2, ebk = bk & 3;
        const int e = 32 * ebk + (F.tid & 31), d0 = 32 * db + (F.tid >> 5), d1 = d0 + 16;
        float s0 = 0.f, s1 = 0.f;
        for (int j = 0; j < 16; ++j) { const int u = bh * 16 + j;
            SIN[(size_t)u * 16384 + d0 * 128 + e] = (bf16_t)(pk2(s0, 0.f) & 0xffffu); SIN[(size_t)u * 16384 + d1 * 128 + e] = (bf16_t)(pk2(s1, 0.f) & 0xffffu);
            s0 = DT[u * 128 + d0] * s0 + SL[(size_t)u * 16384 + d0 * 128 + e]; s1 = DT[u * 128 + d1] * s1 + SL[(size_t)u * 16384 + d1 * 128 + e]; }
    }
}

__device__ __forceinline__ void p5_fixup_unit(Ctx& F, int u) {
    const int bh = u >> 4, jj = u & 15, b = bh >> 2, h = bh & 3;
    const int rowbase = b * SEQ + jj * 256;
    LAS unsigned char* L = F.lds;
    const bf16_t* SIN = (const bf16_t*)(F.ws + WS_SIN) + (size_t)u * 16384;
    const bf16_t* QE = (const bf16_t*)(F.ws + WS_QE); const bf16_t* OLOC = (const bf16_t*)(F.ws + WS_OLOC); const bf16_t* proj = (const bf16_t*)(F.ws + WS_PROJ);
    bf16_t* YC = (bf16_t*)(F.ws + WS_YCAT);
    const int c32 = F.lane & 31, hh = F.lane >> 5, i16 = F.lane & 15, tq = i16 >> 2, tp = i16 & 3, blk = (F.lane >> 4) & 1;
#pragma unroll
    for (int it = 0; it < 4; ++it) { const int idx = F.tid + 512 * it, row = idx >> 4, pc = idx & 15; *(LAS u32x4*)(L + row * 320 + pc * 16) = *(const u32x4*)(SIN + row * 128 + pc * 8); }
    const size_t tok = (size_t)rowbase + 32 * F.wave + c32;
    bf16x8 bq[8];
#pragma unroll
    for (int k = 0; k < 8; ++k) bq[k] = *(const bf16x8*)(QE + tok * 512 + h * 128 + 16 * k + 8 * hh);
    __syncthreads();
    f32x16 acc[4];
#pragma unroll
    for (int et = 0; et < 4; ++et) {
#pragma unroll
        for (int r = 0; r < 16; ++r) acc[et][r] = 0.f;
#pragma unroll
        for (int k = 0; k < 8; ++k) { const LAS unsigned char* sb = L + (16 * k + 8 * hh + tq) * 320 + (32 * et + 16 * blk + 4 * tp) * 2;
            const bf16x8 a = cat8(tr_read(sb), tr_read(sb + 4 * 320)); acc[et] = MFMA32(a, bq[k], acc[et]); }
    }
    float ss = 0.f;
#pragma unroll
    for (int et = 0; et < 4; ++et)
#pragma unroll
        for (int g = 0; g < 4; ++g) { const int e0 = 32 * et + 8 * g + 4 * hh; const u32x2 ol = *(const u32x2*)(OLOC + tok * 512 + h * 128 + e0);
            acc[et][4 * g] += bflo(ol.x); acc[et][4 * g + 1] += bfhi(ol.x); acc[et][4 * g + 2] += bflo(ol.y); acc[et][4 * g + 3] += bfhi(ol.y);
            ss += (acc[et][4 * g] * acc[et][4 * g] + acc[et][4 * g + 1] * acc[et][4 * g + 1]) + (acc[et][4 * g + 2] * acc[et][4 * g + 2] + acc[et][4 * g + 3] * acc[et][4 * g + 3]); }
    ss += __shfl_xor(ss, 32);
    const float rstd = 1.0f / sqrtf(ss * (1.f / 128.f) + EPS);
#pragma unroll
    for (int et = 0; et < 4; ++et)
#pragma unroll
        for (int g = 0; g < 4; ++g) { const int e0 = 32 * et + 8 * g + 4 * hh; const f32x4 nw = *(const f32x4*)((F.ap->in[9]) + h * 128 + e0);
            const u32x2 g2 = *(const u32x2*)(proj + tok * DIN + C_GR + h * 128 + e0);
            const float ga = bflo(g2.x), gb = bfhi(g2.x), gc = bflo(g2.y), gd = bfhi(g2.y);
            u32x2 wv; wv.x = pk2(acc[et][4 * g] * rstd * nw.x * (ga * sigmoidf_(ga)), acc[et][4 * g + 1] * rstd * nw.y * (gb * sigmoidf_(gb)));
            wv.y = pk2(acc[et][4 * g + 2] * rstd * nw.z * (gc * sigmoidf_(gc)), acc[et][4 * g + 3] * rstd * nw.w * (gd * sigmoidf_(gd)));
            *(u32x2*)(YC + tok * 1024 + 512 + h * 128 + e0) = wv; }
    __syncthreads();
}
__device__ __forceinline__ void p5_attn_merge(Ctx& F) {
    const int gw = F.bid * 8 + F.wave, NGW = F.G * 8;
    const bf16_t* PO = (const bf16_t*)(F.ws + WS_PARTO); const float* LS = (const float*)(F.ws + WS_LSE); bf16_t* YC = (bf16_t*)(F.ws + WS_YCAT);
    const int hd = F.lane >> 3, sub = F.lane & 7;
#pragma unroll 2
    for (int tok = gw; tok < T; tok += NGW) {
        float ls[3]; u32x4 o[3];
#pragma unroll
        for (int n = 0; n < 3; ++n) { ls[n] = LS[((size_t)n * T + tok) * 8 + hd]; o[n] = *(const u32x4*)(PO + ((size_t)n * T + tok) * 512 + hd * 64 + sub * 8); }
        const float mx = fmaxf(ls[0], fmaxf(ls[1], ls[2]));
        float wgt[3]; wgt[0] = __expf(ls[0] - mx); wgt[1] = __expf(ls[1] - mx); wgt[2] = __expf(ls[2] - mx);
        const float inv = 1.f / (wgt[0] + wgt[1] + wgt[2]);
        float v[8];
#pragma unroll
        for (int i = 0; i < 8; ++i) v[i] = 0.f;
#pragma unroll
        for (int n = 0; n < 3; ++n) { const float wn = wgt[n] * inv;
            v[0] += wn * bflo(o[n].x); v[1] += wn * bfhi(o[n].x); v[2] += wn * bflo(o[n].y); v[3] += wn * bfhi(o[n].y);
            v[4] += wn * bflo(o[n].z); v[5] += wn * bfhi(o[n].z); v[6] += wn * bflo(o[n].w); v[7] += wn * bfhi(o[n].w); }
        float ss = 0.f;
#pragma unroll
        for (int i = 0; i < 8; ++i) ss += v[i] * v[i];
        ss += __shfl_xor(ss, 1); ss += __shfl_xor(ss, 2); ss += __shfl_xor(ss, 4);
        const float rstd = 1.0f / sqrtf(ss * (1.f / 64.f) + EPS);
        const f32x4 n0 = *(const f32x4*)((F.ap->in[7]) + hd * 64 + sub * 8), n1 = *(const f32x4*)((F.ap->in[7]) + hd * 64 + sub * 8 + 4);
        u32x4 wv; wv.x = pk2(v[0] * rstd * n0.x, v[1] * rstd * n0.y); wv.y = pk2(v[2] * rstd * n0.z, v[3] * rstd * n0.w);
        wv.z = pk2(v[4] * rstd * n1.x, v[5] * rstd * n1.y); wv.w = pk2(v[6] * rstd * n1.z, v[7] * rstd * n1.w);
        *(u32x4*)(YC + (size_t)tok * 1024 + hd * 64 + sub * 8) = wv;
    }
}

__device__ __forceinline__ void p7_load(Ctx& F, int m, u32x2 (&yb)[4], f32x4 (&xv)[4]) {
    const u32x2* yr = (const u32x2*)((const bf16_t*)(F.ws + WS_Y) + (size_t)m * D) + F.lane;
    const f32x4* xr = (const f32x4*)((F.ap->in[0]) + (size_t)m * D) + F.lane;
#pragma unroll
    for (int j = 0; j < 4; ++j) { yb[j] = yr[64 * j]; xv[j] = xr[64 * j]; }
}
struct P7Par { f32x4 gp[4], gm[4], g2[4], sh[4], sc1[4]; };
__device__ __forceinline__ void p7_row(Ctx& F, int m, const u32x2 (&yb)[4], f32x4 (&xv)[4], const P7Par& Q) {
    f32x4 y[4]; float ss = 0.f;
#pragma unroll
    for (int j = 0; j < 4; ++j) { y[j] = (f32x4){bflo(yb[j].x), bfhi(yb[j].x), bflo(yb[j].y), bfhi(yb[j].y)};
        ss += (y[j].x * y[j].x + y[j].y * y[j].y) + (y[j].z * y[j].z + y[j].w * y[j].w); }
    const float rstd1 = 1.0f / sqrtf(wave_sum(ss) * (1.f / D) + EPS);
    u32x2* x2o = (u32x2*)((bf16_t*)(F.ws + WS_X2) + (size_t)m * D) + F.lane;
    float ss2 = 0.f;
#pragma unroll
    for (int j = 0; j < 4; ++j) {
        xv[j] = xv[j] + Q.gm[j] * (y[j] * rstd1 * Q.gp[j]); { u32x2 w2; w2.x = pk2(xv[j].x, xv[j].y); w2.y = pk2(xv[j].z, xv[j].w); x2o[64 * j] = w2; }
        ss2 += (xv[j].x * xv[j].x + xv[j].y * xv[j].y) + (xv[j].z * xv[j].z + xv[j].w * xv[j].w); }
    const float rstd2 = 1.0f / sqrtf(wave_sum(ss2) * (1.f / D) + EPS);
    u32x2* ho = (u32x2*)((bf16_t*)(F.ws + WS_H) + (size_t)m * D) + F.lane;
    u32x2* hl = (u32x2*)((bf16_t*)(F.ws + WS_HLO) + (size_t)m * D) + F.lane;
#pragma unroll
    for (int j = 0; j < 4; ++j) {
        const f32x4 hx = xv[j] * rstd2 * Q.g2[j] * Q.sc1[j] + Q.sh[j];
        u32x2 w; w.x = pk2(hx.x, hx.y); w.y = pk2(hx.z, hx.w); ho[64 * j] = w;
        u32x2 l; l.x = pk2(hx.x - bflo(w.x), hx.y - bfhi(w.x)); l.y = pk2(hx.z - bflo(w.y), hx.w - bfhi(w.y)); hl[64 * j] = l;
        if (MOE_FP8) ((unsigned*)((unsigned char*)(F.ws + WS_H8) + (size_t)m * D) + F.lane)[64 * j] = pk4_fp8(hx.x * F8_SA, hx.y * F8_SA, hx.z * F8_SA, hx.w * F8_SA); }
}
__device__ __forceinline__ void p7_rows(Ctx& F) {
    LAS float* part = (LAS float*)F.lds;
    LAS int* hist = (LAS int*)(F.lds + MISC_OFF); LAS int* gbase = hist + 32; LAS int* pbp = hist + 64; LAS int* pbe = hist + 64 + 256; LAS float* pbg = (LAS float*)(hist + 64 + 512);
    unsigned* cnt = (unsigned*)(F.ws + WS_CTL) + CW_CNT; u32x2* TOK = (u32x2*)(F.ws + WS_TOK);
    const bf16_t* H = (const bf16_t*)(F.ws + WS_H); const bf16_t* HLO = (const bf16_t*)(F.ws + WS_HLO); const bf16_t* WRT = (const bf16_t*)(F.ws + WS_WRT);
    const int c32 = F.lane & 31, hh = F.lane >> 5, tt = F.wave & 1, kq = F.wave >> 1;
    for (int rb = F.bid; rb < T / 64; rb += F.G) {
        if (F.tid < 32) hist[F.tid] = 0;
        { const float* mod = (const float*)(F.ws + WS_MOD); const int b = (rb * 64) / SEQ; P7Par Q;
#pragma unroll
          for (int j = 0; j < 4; ++j) { const int k = 4 * F.lane + 256 * j;
              Q.gp[j] = *(const f32x4*)((F.ap->in[5]) + k); Q.gm[j] = *(const f32x4*)(mod + b * 6144 + 2048 + k); Q.g2[j] = *(const f32x4*)((F.ap->in[11]) + k);
              Q.sh[j] = *(const f32x4*)(mod + b * 6144 + 3072 + k); Q.sc1[j] = *(const f32x4*)(mod + b * 6144 + 4096 + k) + 1.0f; }
          u32x2 y0[4], y1[4]; f32x4 x0[4], x1[4]; const int mb = rb * 64 + F.wave * 8;
          p7_load(F, mb, y0, x0); p7_load(F, mb + 1, y1, x1);
          for (int i = 0; i < 8; ++i) { u32x2 yb[4]; f32x4 xv[4];
#pragma unroll
              for (int j = 0; j < 4; ++j) { yb[j] = y0[j]; xv[j] = x0[j]; y0[j] = y1[j]; x0[j] = x1[j]; }
              if (i < 6) p7_load(F, mb + i + 2, y1, x1);
              p7_row(F, mb + i, yb, xv, Q); } }
        asm volatile("s_waitcnt vmcnt(0)" ::: "memory");
        __syncthreads();
        const size_t tok = (size_t)rb * 64 + 32 * tt + c32;
        f32x16 acc;
#pragma unroll
        for (int r = 0; r < 16; ++r) acc[r] = 0.f;
#pragma unroll 8
        for (int s = 0; s < 16; ++s) { const int k0 = 256 * kq + 16 * s + 8 * hh;
            const bf16x8 bh = *(const bf16x8*)(H + tok * 1024 + k0), bl = *(const bf16x8*)(HLO + tok * 1024 + k0);
            const bf16x8 ah = *(const bf16x8*)(WRT + c32 * 1024 + k0), al = *(const bf16x8*)(WRT + 32768 + c32 * 1024 + k0);
            acc = MFMA32(ah, bh, acc); acc = MFMA32(ah, bl, acc); acc = MFMA32(al, bh, acc); }
#pragma unroll
        for (int r = 0; r < 16; ++r) part[(F.wave * 16 + r) * 64 + F.lane] = acc[r];
        __syncthreads();
        if (kq == 0) {
            float v[16];
#pragma unroll
            for (int r = 0; r < 16; ++r) v[r] = part[((0 * 2 + tt) * 16 + r) * 64 + F.lane] + part[((1 * 2 + tt) * 16 + r) * 64 + F.lane] + part[((2 * 2 + tt) * 16 + r) * 64 + F.lane] + part[((3 * 2 + tt) * 16 + r) * 64 + F.lane] + (F.ap->in[14])[crow(r, hh)];
            float cv[8]; int ci[8];
#pragma unroll
            for (int kk = 0; kk < 4; ++kk) { float best = -INFINITY; int bi = 0;
#pragma unroll
                for (int r = 0; r < 16; ++r) { const bool gt = v[r] > best; best = gt ? v[r] : best; bi = gt ? crow(r, hh) : bi; }
                cv[kk] = best; ci[kk] = bi;
#pragma unroll
                for (int r = 0; r < 16; ++r) v[r] = (crow(r, hh) == bi) ? -INFINITY : v[r]; }
#pragma unroll
            for (int kk = 0; kk < 4; ++kk) { cv[4 + kk] = __shfl_xor(cv[kk], 32); ci[4 + kk] = __shfl_xor(ci[kk], 32); }
            float val[4]; int idx[4];
#pragma unroll
            for (int kk = 0; kk < 4; ++kk) { float best = -INFINITY; int bi = 1 << 20;
#pragma unroll
                for (int q = 0; q < 8; ++q) { const bool gt = (cv[q] > best) || (cv[q] == best && ci[q] < bi); best = gt ? cv[q] : best; bi = gt ? ci[q] : bi; }
                val[kk] = best; idx[kk] = bi;
#pragma unroll
                for (int q = 0; q < 8; ++q) cv[q] = (ci[q] == bi) ? -INFINITY : cv[q]; }
            float g[4]; float sg = 0.f;
#pragma unroll
            for (int kk = 0; kk < 4; ++kk) { g[kk] = __expf(val[kk] - val[0]); sg += g[kk]; }
            const float inv = 1.f / sg;
            if (hh == 0) { const int mloc = 32 * tt + c32; const int m = rb * 64 + mloc;
#pragma unroll
                for (int kk = 0; kk < 4; ++kk) { const int rank = atomicAdd((int*)(hist + idx[kk]), 1); const int slot = mloc * 4 + kk;
                    pbp[slot] = m * 4 + kk; pbe[slot] = idx[kk] | (rank << 8); pbg[slot] = g[kk] * inv; } }
        }
        __syncthreads();
        if (F.tid < 32) gbase[F.tid] = (int)atomicAdd(cnt + 64 * F.tid, (unsigned)hist[F.tid]);
        __syncthreads();
        if (F.tid < 256) { const int e = pbe[F.tid] & 255, rank = pbe[F.tid] >> 8; TOK[e * LIST_CAP + gbase[e] + rank] = (u32x2){(unsigned)pbp[F.tid], __float_as_uint(pbg[F.tid])}; }
        __syncthreads();
    }
}

__device__ __forceinline__ void moe_tables(Ctx& F, LAS int* cntl, LAS int* tbase, LAS int* tile_e) {
    const unsigned* cnt = (const unsigned*)(F.ws + WS_CTL) + CW_CNT;
    if (F.tid < NE) cntl[F.tid] = (int)__hip_atomic_load(cnt + 64 * F.tid, __ATOMIC_RELAXED, __HIP_MEMORY_SCOPE_AGENT);
    __syncthreads();
    if (F.tid <= NE) { int base = 0;
        for (int e = 0; e < F.tid; ++e) base += (cntl[e] + 255) >> 8;
        tbase[F.tid] = base; }
    __syncthreads();
    if (F.tid < 320) { int e = 0;
        for (int q = 1; q < NE; ++q) e = (tbase[q] <= F.tid) ? q : e;
        tile_e[F.tid] = e; }
    __syncthreads();
}

__device__ __forceinline__ void p10_load(Ctx& F, int m, u32x4 (&yp)[2][4], u32x4 (&xv)[2]) {
    const bf16_t* YP = (const bf16_t*)(F.ws + WS_YPAIR); const bf16_t* X2 = (const bf16_t*)(F.ws + WS_X2);
#pragma unroll
    for (int j = 0; j < 2; ++j) {
#pragma unroll
        for (int kk = 0; kk < 4; ++kk) yp[j][kk] = *((const u32x4*)(YP + ((size_t)m * 4 + kk) * 1024) + F.lane + 64 * j);
        xv[j] = ((const u32x4*)(X2 + (size_t)m * D) + F.lane)[64 * j]; }
}
__device__ __forceinline__ void p10_final(Ctx& F) {
    const int gw = F.bid * 8 + F.wave, NGW = F.G * 8;
    const float* mod = (const float*)(F.ws + WS_MOD); const float* gpf = (F.ap->in[12]); float* outp = (F.ap->out);
    f32x4 gp[2][2], gf[2][2]; int bcur = -1;
#pragma unroll
    for (int j = 0; j < 2; ++j) { const int k = 8 * F.lane + 512 * j; gp[j][0] = *(const f32x4*)(gpf + k); gp[j][1] = *(const f32x4*)(gpf + k + 4); }
    u32x4 yp0[2][4], yp1[2][4]; u32x4 xv0[2], xv1[2];
    if (gw < T) p10_load(F, gw, yp0, xv0);
    if (gw + NGW < T) p10_load(F, gw + NGW, yp1, xv1);
    for (int m = gw; m < T; m += NGW) {
        const int b = m / SEQ;
        if (b != bcur) { bcur = b;
#pragma unroll
            for (int j = 0; j < 2; ++j) { const int k = 8 * F.lane + 512 * j; gf[j][0] = *(const f32x4*)(mod + b * 6144 + 5120 + k); gf[j][1] = *(const f32x4*)(mod + b * 6144 + 5120 + k + 4); } }
        float y[2][8]; u32x4 xv[2]; float ss = 0.f;
#pragma unroll
        for (int j = 0; j < 2; ++j) { xv[j] = xv0[j]; xv0[j] = xv1[j];
#pragma unroll
            for (int i = 0; i < 8; ++i) y[j][i] = 0.f;
#pragma unroll
            for (int kk = 0; kk < 4; ++kk) { const u32x4 v = yp0[j][kk]; yp0[j][kk] = yp1[j][kk];
                y[j][0] += bflo(v.x); y[j][1] += bfhi(v.x); y[j][2] += bflo(v.y); y[j][3] += bfhi(v.y); y[j][4] += bflo(v.z); y[j][5] += bfhi(v.z); y[j][6] += bflo(v.w); y[j][7] += bfhi(v.w); }
#pragma unroll
            for (int i = 0; i < 8; ++i) ss += y[j][i] * y[j][i]; }
        if (m + 2 * NGW < T) p10_load(F, m + 2 * NGW, yp1, xv1);
        const float rstd = 1.0f / sqrtf(wave_sum(ss) * (1.f / D) + EPS);
#pragma unroll
        for (int j = 0; j < 2; ++j) { const int k = 8 * F.lane + 512 * j;
            const f32x4 gp0 = gp[j][0] * rstd, gp1 = gp[j][1] * rstd, gf0 = gf[j][0], gf1 = gf[j][1];
            f32x4 o0, o1;
            o0.x = bflo(xv[j].x) + gf0.x * (y[j][0] * gp0.x); o0.y = bfhi(xv[j].x) + gf0.y * (y[j][1] * gp0.y); o0.z = bflo(xv[j].y) + gf0.z * (y[j][2] * gp0.z); o0.w = bfhi(xv[j].y) + gf0.w * (y[j][3] * gp0.w);
            o1.x = bflo(xv[j].z) + gf1.x * (y[j][4] * gp1.x); o1.y = bfhi(xv[j].z) + gf1.y * (y[j][5] * gp1.y); o1.z = bflo(xv[j].w) + gf1.z * (y[j][6] * gp1.z); o1.w = bfhi(xv[j].w) + gf1.w * (y[j][7] * gp1.w);
            f32x4* o = (f32x4*)(outp + (size_t)m * D + k); o[0] = o0; o[1] = o1; }
    }
}

__device__ __forceinline__ bool relaunder(Ctx& F) { CArgs p = (CArgs)__builtin_amdgcn_kernarg_segment_ptr(); asm volatile("" : "+s"(p)); F.ap = p; return true; }
__global__ void __launch_bounds__(512, 2) fwd(Args args) {
    extern __shared__ __attribute__((aligned(16))) unsigned char lds_raw[];
    Ctx F;
    F.lds = (LAS unsigned char*)lds_raw;
    F.tid = threadIdx.x; F.lane = F.tid & 63; F.wave = __builtin_amdgcn_readfirstlane(F.tid >> 6); F.G = gridDim.x; F.bid = blockIdx.x;
    F.ap = (CArgs)__builtin_amdgcn_kernarg_segment_ptr(); F.ws = F.ap->ws;
    volatile LAS unsigned* barw = (volatile LAS unsigned*)(F.lds + BARW_OFF);
    if (F.tid < 4) barw[F.tid] = 0u;
    __syncthreads();
    XcdBarrier bar; bar.bar = (unsigned*)(F.ws + WS_CTL) + CW_BAR; bar.x = 0; bar.st = barw;
    if (MK_N_LAUNCHES == 1) bar = xcd_barrier_post((unsigned*)(F.ws + WS_CTL) + CW_BAR, barw);
    const int lo = F.ap->ph_lo, hi = F.ap->ph_hi; (void)args;
#ifndef PH_MASK
#define PH_MASK 0x7ff
#endif
#define IN(k) ((((PH_MASK) >> (k)) & 1) && lo <= (k) && (k) < hi && relaunder(F))
#define SEAM(k) do { if (IN(k) && IN((k) + 1)) xcd_barrier(bar); } while (0)

#ifndef REPEAT_MASK
#define REPEAT_MASK 0
#endif
#define NREP(k) ((((REPEAT_MASK) >> (k)) & 1) ? 2 : 1)
#define REPBAR(rep) do { if (rep) xcd_barrier(bar); } while (0)
    if (IN(0)) { _Pragma("unroll") for (int rep = 0; rep < NREP(0); ++rep) { REPBAR(rep); p0_prologue(F); } } SEAM(0);
    if (IN(1)) { _Pragma("unroll") for (int rep = 0; rep < NREP(1); ++rep) { REPBAR(rep); p1_norm_mod(F); } } SEAM(1);
    if (IN(2)) { _Pragma("unroll") for (int rep = 0; rep < NREP(2); ++rep) { REPBAR(rep);
        pg8::ProbPlain<G1_FP8 ? 1 : 2> P{(const void*)(F.ws + WS_H), (const void*)(F.ws + WS_WIN), (const int*)(F.ws + WS_IDENT)}; pg8::StaticOrder S; S.init(T, DIN, F.G, F.bid);
        pg8::EpiBf16 E{(bf16_t*)(F.ws + WS_PROJ), DIN, G1_FP8 ? 1.f / (F8_SA * F8_SW) : 1.f};
        pg8::gemm_phase<pg8::EpiBf16, pg8::StaticOrder, pg8::ProbPlain<G1_FP8 ? 1 : 2>>(F.lds, P, S, E);
    } } SEAM(2);
    if (IN(3)) { _Pragma("unroll") for (int rep = 0; rep < NREP(3); ++rep) { REPBAR(rep);
        for (int u = F.bid; u < 256; u += F.G) hgrn_local_unit(F, u);
        if ((REPEAT_MASK) & 2048) { xcd_barrier(bar); for (int u = F.bid; u < 256; u += F.G) hgrn_local_unit(F, u); }
        attn_units(F);
        if ((REPEAT_MASK) & 4096) { xcd_barrier(bar); attn_units(F); }
    } } SEAM(3);
    if (IN(4)) { _Pragma("unroll") for (int rep = 0; rep < NREP(4); ++rep) { REPBAR(rep); p4_scan(F); } } SEAM(4);
    if (IN(5)) { _Pragma("unroll") for (int rep = 0; rep < NREP(5); ++rep) { REPBAR(rep);
        for (int u = F.bid; u < 256; u += F.G) p5_fixup_unit(F, u);
        p5_attn_merge(F);
    } } SEAM(5);
    if (IN(6)) { _Pragma("unroll") for (int rep = 0; rep < NREP(6); ++rep) { REPBAR(rep);
        pg8::ProbPlain<2> P{(const void*)(F.ws + WS_YCAT), (const void*)(F.ws + WS_WOUT), (const int*)(F.ws + WS_IDENT)}; pg8::StaticOrder S; S.init(T, D, F.G, F.bid);
        pg8::EpiBf16 E{(bf16_t*)(F.ws + WS_Y), D, 1.f};
        pg8::gemm_phase<pg8::EpiBf16, pg8::StaticOrder, pg8::ProbPlain<2>>(F.lds, P, S, E);
    } } SEAM(6);
    if (IN(7)) { p7_rows(F); } SEAM(7);
    if (IN(8)) { _Pragma("unroll") for (int rep = 0; rep < NREP(8); ++rep) { REPBAR(rep);
        LAS int* cntl = (LAS int*)(F.lds + MISC_OFF); LAS int* tbase = cntl + 32; LAS int* tile_e = cntl + 128;
        moe_tables(F, cntl, tbase, tile_e);
        pg8::ProbGU<MOE_FP8 ? 1 : 2> P{(const void*)(F.ws + (MOE_FP8 ? WS_H8 : WS_H)), (const void*)(F.ws + WS_WGU), (const int*)(F.ws + WS_TOK)};
        pg8::MoeOrder S{cntl, tbase, tile_e, 8, F.G, F.bid};
        pg8::EpiGU<MOE_FP8 != 0> E{(void*)(F.ws + WS_ACT), (F.ap->in[16])};
        pg8::gemm_phase<pg8::EpiGU<MOE_FP8 != 0>, pg8::MoeOrder, pg8::ProbGU<MOE_FP8 ? 1 : 2>>(F.lds, P, S, E);
    } } SEAM(8);
    if (IN(9)) { _Pragma("unroll") for (int rep = 0; rep < NREP(9); ++rep) { REPBAR(rep);
        LAS int* cntl = (LAS int*)(F.lds + MISC_OFF); LAS int* tbase = cntl + 32; LAS int* tile_e = cntl + 128;
        moe_tables(F, cntl, tbase, tile_e);
        pg8::ProbDown<MOE_FP8 ? 1 : 2> P{(const void*)(F.ws + WS_ACT), (const void*)(F.ws + WS_WDN), (const int*)(F.ws + WS_IDENT)};
        pg8::MoeOrder S{cntl, tbase, tile_e, 4, F.G, F.bid};
        pg8::EpiDown<MOE_FP8 != 0> E{(bf16_t*)(F.ws + WS_YPAIR), (F.ap->in[18]), (const int*)(F.ws + WS_TOK)};
        pg8::gemm_phase<pg8::EpiDown<MOE_FP8 != 0>, pg8::MoeOrder, pg8::ProbDown<MOE_FP8 ? 1 : 2>>(F.lds, P, S, E);
    } } SEAM(9);
    if (IN(10)) { _Pragma("unroll") for (int rep = 0; rep < NREP(10); ++rep) { REPBAR(rep); p10_final(F); } }
#undef IN
#undef SEAM
}

extern "C" void kernel_launch(void* const* d_in, const int* in_sizes, int n_in, void* d_out, int out_size, void* d_ws, size_t ws_size, hipStream_t stream) {
    static int grid = 0;
    if (grid == 0) {
        if (n_in != 19 || out_size != T * D || ws_size < WS_END) { fprintf(stderr, "kernel_launch: unexpected problem (n_in %d, out %d, ws %zu)\n", n_in, out_size, ws_size); grid = -1; return; }
        int dev = 0, cus = 0, per_cu = 0;
        if (hipGetDevice(&dev) != hipSuccess || hipDeviceGetAttribute(&cus, hipDeviceAttributeMultiprocessorCount, dev) != hipSuccess) { grid = -1; return; }
        if (hipFuncSetAttribute((const void*)fwd, hipFuncAttributeMaxDynamicSharedMemorySize, LDS_BYTES) != hipSuccess) { fprintf(stderr, "kernel_launch: hipFuncSetAttribute failed\n"); grid = -1; return; }
        if (hipOccupancyMaxActiveBlocksPerMultiprocessor(&per_cu, (const void*)fwd, 512, LDS_BYTES) != hipSuccess || per_cu < 1) { fprintf(stderr, "kernel_launch: occupancy query reports %d\n", per_cu); }
        (void)hipGetLastError();
        grid = cus;
    }
    if (grid < 0) return;
    (void)hipMemsetAsync((char*)d_ws + WS_CTL, 0, CTL_ZERO_BYTES, stream);
    Args a{};
    for (int i = 0; i < 19; ++i) a.in[i] = (const float*)d_in[i];
    a.out = (float*)d_out; a.ws = (unsigned char*)d_ws;
#if MK_N_LAUNCHES == 1
#ifdef PROBE_PREFIX
    a.ph_lo = 0; a.ph_hi = PROBE_PREFIX;
    hipLaunchKernelGGL(fwd, dim3(grid), dim3(512), LDS_BYTES, stream, a);
    (void)hipMemsetAsync((char*)d_ws + WS_CTL, 0, CTL_ZERO_BYTES, stream);
#endif
    a.ph_lo = 0; a.ph_hi = NPHASE;
    hipLaunchKernelGGL(fwd, dim3(grid), dim3(512), LDS_BYTES, stream, a);
#else
    for (int li = 0; li < NPHASE; ++li) { a.ph_lo = li; a.ph_hi = li + 1; hipLaunchKernelGGL(fwd, dim3(grid), dim3(512), LDS_BYTES, stream, a); }
#endif
}
```
